# Optimizing an MI355X kernel written in HIP

```python
import math
import jax, jax.numpy as jnp
from jax import lax
import numpy as np

D_MODEL = 1024
BATCH = 16
SEQ = 2048
DEPTH = 2

D_MIX = D_MODEL
HG_WIDTH = D_MIX // 4
HG_HEADS = 4
HG_DK = HG_WIDTH // HG_HEADS
HG_CHUNK = 32
S5_WIDTH = D_MIX // 4
S5_GROUP = 16
S5_GROUPS = S5_WIDTH // S5_GROUP
S5_STATE = 64
ML_WIDTH = D_MIX - HG_WIDTH - S5_WIDTH
ML_HEADS = 4
ML_DH = ML_WIDTH // ML_HEADS
ML_CHUNK = 64
CONV_WIDTH = 4
D_FF = -(-8 * D_MODEL // (3 * 256)) * 256
D_IN = 4 * HG_WIDTH + S5_WIDTH + 2 * ML_WIDTH
EPS = 1e-6

kernel_name = "hybrid_hgrn2_s5_mlstm_block"


def rmsnorm(x, g):
    xf = x.astype(jnp.float32)
    y = xf * lax.rsqrt(jnp.mean(xf * xf, axis=-1, keepdims=True) + EPS)
    return (y * g.astype(jnp.float32)).astype(x.dtype)


def causal_conv(x, w, b):
    S = x.shape[1]
    K = w.shape[0]
    xp = jnp.pad(x, ((0, 0), (K - 1, 0), (0, 0)))
    y = xp[:, 0:S] * w[0]
    for k in range(1, K):
        y = y + xp[:, k:k + S] * w[k]
    return y + b


def hgrn2_mix(q_raw, f_raw, i_raw, g_raw, lb, norm_g):
    B, S, _ = q_raw.shape
    H, dk, L = HG_HEADS, HG_DK, HG_CHUNK
    N = S // L
    q = jax.nn.silu(q_raw)
    zf = f_raw.astype(jnp.float32)
    lb = lb.astype(jnp.float32)
    log_f = jnp.logaddexp(jnp.log(lb), jnp.log1p(-lb) + jax.nn.log_sigmoid(zf))
    k = (1.0 - lb) * jax.nn.sigmoid(-zf)

    def chunk(t):
        return t.reshape(B, N, L, H, -1).transpose(0, 3, 1, 2, 4)

    qc, kc, vc, gc = chunk(q), chunk(k), chunk(i_raw), chunk(log_f)
    b = jnp.cumsum(gc, axis=3)
    b_last = b[:, :, :, -1]
    q_dec = qc * jnp.exp(b)
    k_inv = kc * jnp.exp(-b)
    k_end = kc * jnp.exp(b_last[:, :, :, None] - b)
    causal = jnp.tril(jnp.ones((L, L), dtype=bool))
    scores = jnp.where(causal, jnp.einsum('bhntd,bhnsd->bhnts', q_dec, k_inv), 0.0)
    o_intra = jnp.einsum('bhnts,bhnse->bhnte', scores, vc)
    dS = jnp.einsum('bhnsd,bhnse->bhnde', k_end, vc)
    decay = jnp.exp(b_last)

    def step(S_, inp):
        dec, ds = inp
        return dec[..., None] * S_ + ds, S_

    S0 = jnp.zeros((B, H, dk, vc.shape[-1]), dS.dtype)
    _, S_prev = lax.scan(step, S0, (jnp.moveaxis(decay, 2, 0), jnp.moveaxis(dS, 2, 0)))
    S_prev = jnp.moveaxis(S_prev, 0, 2)
    o_inter = jnp.einsum('bhntd,bhnde->bhnte', q_dec, S_prev)
    o = (o_intra + o_inter).transpose(0, 2, 3, 1, 4).reshape(B, S, H, -1)
    o = rmsnorm(o, norm_g.reshape(H, -1))
    o = o * jax.nn.silu(g_raw.reshape(B, S, H, -1))
    return o.reshape(B, S, HG_WIDTH)


def complex_affine_combine(e1, e2):
    a1r, a1i, b1r, b1i = e1
    a2r, a2i, b2r, b2i = e2
    return (a2r * a1r - a2i * a1i,
            a2r * a1i + a2i * a1r,
            a2r * b1r - a2i * b1i + b2r,
            a2r * b1i + a2i * b1r + b2i)


def s5_mix(u, lam_re, lam_im, log_dt, b_re, b_im, c_re, c_im, d, w_glu):
    B, S, _ = u.shape
    G, P = S5_GROUPS, S5_STATE
    ug = u.reshape(B, S, G, S5_GROUP)
    lre = lam_re.astype(jnp.float32)
    lim = lam_im.astype(jnp.float32)
    dt = jnp.exp(log_dt.astype(jnp.float32))[:, None]
    mag = jnp.exp(lre * dt)
    ang = lim * dt
    ar, ai = mag * jnp.cos(ang), mag * jnp.sin(ang)
    den = lre * lre + lim * lim
    nr, ni = ar - 1.0, ai
    cr = (nr * lre + ni * lim) / den
    ci = (ni * lre - nr * lim) / den
    bbr = cr[..., None] * b_re - ci[..., None] * b_im
    bbi = cr[..., None] * b_im + ci[..., None] * b_re
    bu_r = jnp.einsum('bsgh,gph->bsgp', ug, bbr)
    bu_i = jnp.einsum('bsgh,gph->bsgp', ug, bbi)
    a_r = jnp.broadcast_to(ar[None, None], (1, S, G, P))
    a_i = jnp.broadcast_to(ai[None, None], (1, S, G, P))
    _, _, xr, xi = lax.associative_scan(complex_affine_combine, (a_r, a_i, bu_r, bu_i), axis=1)
    y = jnp.einsum('bsgp,ghp->bsgh', xr, c_re) - jnp.einsum('bsgp,ghp->bsgh', xi, c_im)
    y = y.reshape(B, S, S5_WIDTH) + d * u
    y = jax.nn.gelu(y)
    return y * jax.nn.sigmoid(y @ w_glu)


def mlstm_mix(x_m, z, conv_w, conv_b, wq, wk, wv, w_gates, b_gates, norm_g, skip):
    B, S, _ = x_m.shape
    H, dh, L = ML_HEADS, ML_DH, ML_CHUNK
    N = S // L
    xc = jax.nn.silu(causal_conv(x_m, conv_w, conv_b))
    xch = xc.reshape(B, S, H, dh)
    xmh = x_m.reshape(B, S, H, dh)
    q = jnp.einsum('bshd,hde->bshe', xch, wq)
    k = jnp.einsum('bshd,hde->bshe', xch, wk) * (dh ** -0.5)
    v = jnp.einsum('bshd,hde->bshe', xmh, wv)
    qkv = jnp.concatenate([q.reshape(B, S, -1), k.reshape(B, S, -1), v.reshape(B, S, -1)], axis=-1)
    gates = (qkv @ w_gates + b_gates).astype(jnp.float32)
    ig = gates[..., :H]
    log_f = jax.nn.log_sigmoid(gates[..., H:])

    def chunk(t):
        return t.reshape(B, N, L, H, -1).transpose(0, 3, 1, 2, 4)

    def chunk_g(t):
        return t.reshape(B, N, L, H).transpose(0, 3, 1, 2)

    qc, kc, vc = chunk(q), chunk(k), chunk(v)
    igc, lfc = chunk_g(ig), chunk_g(log_f)
    b = jnp.cumsum(lfc, axis=-1)
    b_last = b[..., -1]
    a = b_last[..., None] - b + igc
    m_loc = jnp.max(a, axis=-1)
    w_loc = jnp.exp(a - m_loc[..., None])
    dC = jnp.einsum('bhns,bhnsd,bhnse->bhnde', w_loc, kc, vc)
    dn = jnp.einsum('bhns,bhnsd->bhnd', w_loc, kc)

    def step(carry, inp):
        C_, n_, m_ = carry
        g, ml, dc, dnn = inp
        m_new = jnp.maximum(g + m_, ml)
        sp = jnp.exp(g + m_ - m_new)
        sl = jnp.exp(ml - m_new)
        C_new = sp[..., None, None] * C_ + sl[..., None, None] * dc
        n_new = sp[..., None] * n_ + sl[..., None] * dnn
        return (C_new, n_new, m_new), (C_, n_, m_)

    init = (jnp.zeros((B, H, dh, dh), dC.dtype), jnp.zeros((B, H, dh), dn.dtype),
            jnp.zeros((B, H), m_loc.dtype))
    xs = (jnp.moveaxis(b_last, 2, 0), jnp.moveaxis(m_loc, 2, 0),
          jnp.moveaxis(dC, 2, 0), jnp.moveaxis(dn, 2, 0))
    _, (C_prev, n_prev, m_prev) = lax.scan(step, init, xs)
    C_prev = jnp.moveaxis(C_prev, 0, 2)
    n_prev = jnp.moveaxis(n_prev, 0, 2)
    m_prev = jnp.moveaxis(m_prev, 0, 2)

    causal = jnp.tril(jnp.ones((L, L), dtype=bool))
    logD = jnp.where(causal, b[..., :, None] - b[..., None, :] + igc[..., None, :], -jnp.inf)
    inter = b + m_prev[..., None]
    m_t = jnp.maximum(jnp.max(logD, axis=-1), inter)
    Dm = jnp.exp(logD - m_t[..., None])
    W = jnp.einsum('bhntd,bhnsd->bhnts', qc, kc) * Dm
    sc = jnp.exp(inter - m_t)
    num = (jnp.einsum('bhnts,bhnse->bhnte', W, vc)
           + sc[..., None] * jnp.einsum('bhntd,bhnde->bhnte', qc, C_prev))
    den = jnp.sum(W, axis=-1) + sc * jnp.einsum('bhntd,bhnd->bhnt', qc, n_prev)
    h = num / jnp.maximum(jnp.abs(den), jnp.exp(-m_t))[..., None]
    h = h.transpose(0, 2, 3, 1, 4).reshape(B, S, H, dh)
    h = rmsnorm(h, norm_g.reshape(H, dh)).reshape(B, S, ML_WIDTH)
    return (h + skip * xc) * jax.nn.silu(z)


def setup_inputs(seed: int = 0) -> dict:
    key = jax.random.key(seed)
    ks = iter(jax.random.split(key, 40))

    def nrm(shape, scale):
        return jax.random.normal(next(ks), shape, jnp.float32) * scale

    L = DEPTH
    G, P, H = S5_GROUPS, S5_STATE, ML_HEADS
    n_idx = jnp.arange(P, dtype=jnp.float32)
    log_dt_min, log_dt_max = math.log(0.001), math.log(0.1)
    return {
        "x": nrm((BATCH, SEQ, D_MODEL), 1.0),
        "norm_mix_g": 1.0 + nrm((L, D_MODEL), 0.02),
        "w_in": nrm((L, D_MODEL, D_IN), D_MODEL ** -0.5),
        "hgrn_lb_raw": nrm((L, HG_WIDTH), 0.5),
        "hgrn_norm_g": 1.0 + nrm((L, HG_WIDTH), 0.02),
        "s5_lambda_re": -0.5 + nrm((L, G, P), 0.01),
        "s5_lambda_im": math.pi * n_idx + nrm((L, G, P), 0.01),
        "s5_log_dt": log_dt_min + jax.random.uniform(next(ks), (L, G), jnp.float32) * (log_dt_max - log_dt_min),
        "s5_b_re": nrm((L, G, P, S5_GROUP), (2 * S5_GROUP) ** -0.5),
        "s5_b_im": nrm((L, G, P, S5_GROUP), (2 * S5_GROUP) ** -0.5),
        "s5_c_re": nrm((L, G, S5_GROUP, P), P ** -0.5),
        "s5_c_im": nrm((L, G, S5_GROUP, P), P ** -0.5),
        "s5_d": nrm((L, S5_WIDTH), 1.0),
        "s5_w_glu": nrm((L, S5_WIDTH, S5_WIDTH), S5_WIDTH ** -0.5),
        "ml_conv_w": nrm((L, CONV_WIDTH, ML_WIDTH), CONV_WIDTH ** -0.5),
        "ml_conv_b": nrm((L, ML_WIDTH), 0.02),
        "ml_wq": nrm((L, H, ML_DH, ML_DH), ML_DH ** -0.5),
        "ml_wk": nrm((L, H, ML_DH, ML_DH), ML_DH ** -0.5),
        "ml_wv": nrm((L, H, ML_DH, ML_DH), ML_DH ** -0.5),
        "ml_w_gates": nrm((L, 3 * ML_WIDTH, 2 * H), 0.1 * (3 * ML_WIDTH) ** -0.5),
        "ml_b_gates": jnp.concatenate([nrm((L, H), 0.1),
                                       jnp.linspace(3.0, 6.0, H, dtype=jnp.float32)[None] + nrm((L, H), 0.01)], axis=-1),
        "ml_norm_g": 1.0 + nrm((L, ML_WIDTH), 0.02),
        "ml_skip": 1.0 + nrm((L, ML_WIDTH), 0.02),
        "w_out": nrm((L, D_MIX, D_MODEL), D_MIX ** -0.5),
        "norm_ffn_g": 1.0 + nrm((L, D_MODEL), 0.02),
        "ffn_w_gate": nrm((L, D_MODEL, D_FF), D_MODEL ** -0.5),
        "ffn_w_up": nrm((L, D_MODEL, D_FF), D_MODEL ** -0.5),
        "ffn_w_down": nrm((L, D_FF, D_MODEL), D_FF ** -0.5),
        "norm_final_g": 1.0 + nrm((D_MODEL,), 0.02),
    }


def reference(x, norm_mix_g, w_in, hgrn_lb_raw, hgrn_norm_g, s5_lambda_re, s5_lambda_im, s5_log_dt,
              s5_b_re, s5_b_im, s5_c_re, s5_c_im, s5_d, s5_w_glu, ml_conv_w, ml_conv_b, ml_wq, ml_wk,
              ml_wv, ml_w_gates, ml_b_gates, ml_norm_g, ml_skip, w_out, norm_ffn_g, ffn_w_gate,
              ffn_w_up, ffn_w_down, norm_final_g):
    lb_cs = jnp.cumsum(jax.nn.softmax(hgrn_lb_raw.astype(jnp.float32), axis=0), axis=0)
    lb_all = lb_cs - lb_cs[0]
    splits = [HG_WIDTH, 2 * HG_WIDTH, 3 * HG_WIDTH, 4 * HG_WIDTH,
              4 * HG_WIDTH + S5_WIDTH, 4 * HG_WIDTH + S5_WIDTH + ML_WIDTH]
    for l in range(DEPTH):
        h = rmsnorm(x, norm_mix_g[l])
        p = h @ w_in[l]
        hg_q, hg_f, hg_i, hg_g, s5_u, ml_x, ml_z = jnp.split(p, splits, axis=-1)
        o_hg = hgrn2_mix(hg_q, hg_f, hg_i, hg_g, lb_all[l], hgrn_norm_g[l])
        o_s5 = s5_mix(s5_u, s5_lambda_re[l], s5_lambda_im[l], s5_log_dt[l], s5_b_re[l], s5_b_im[l],
                      s5_c_re[l], s5_c_im[l], s5_d[l], s5_w_glu[l])
        o_ml = mlstm_mix(ml_x, ml_z, ml_conv_w[l], ml_conv_b[l], ml_wq[l], ml_wk[l], ml_wv[l],
                         ml_w_gates[l], ml_b_gates[l], ml_norm_g[l], ml_skip[l])
        mix = jnp.concatenate([o_hg, o_s5, o_ml], axis=-1) @ w_out[l]
        x = x + mix.astype(x.dtype)
        h = rmsnorm(x, norm_ffn_g[l])
        ff = (jax.nn.silu(h @ ffn_w_gate[l]) * (h @ ffn_w_up[l])) @ ffn_w_down[l]
        x = x + ff.astype(x.dtype)
    return rmsnorm(x, norm_final_g)
```

```cpp
#include <hip/hip_runtime.h>
#include <cstdio>
#include <cstdint>
namespace pg8 {
#define PG8_LAS __attribute__((address_space(3)))
typedef unsigned short bf16_t;
typedef short bf16x8 __attribute__((ext_vector_type(8)));
typedef float f32x4 __attribute__((ext_vector_type(4)));
typedef unsigned u32x4 __attribute__((ext_vector_type(4)));
constexpr int BM = 256, BK = 64, HALF = 128, HTB = HALF * BK * 2  , STAGE_BYTES = 8 * HTB, NXCD = 8, WGM = 8;

__host__ __device__ __forceinline__ int lds_byte(int r, int c) { const int st = (r >> 4) * 2 + (c >> 5), rr = r & 15, cc = c & 31, ob = rr * 64 + cc * 2; return st * 1024 + (ob ^ (((ob >> 9) & 1) << 5)); }
__host__ __device__ __forceinline__ void stage_rc(int b, int& R, int& C) { const int st = b / 1024, sb = b % 1024, swz = sb ^ (((sb >> 9) & 1) << 5); R = (st >> 1) * 16 + swz / 64; C = (st & 1) * 32 + (swz % 64) / 2; }
__host__ __device__ __forceinline__ int perm32(int rho) { const int n = rho >> 4, i = rho & 15; return 8 * (i >> 2) + 4 * n + (i & 3); }

struct Unit { int pm, pn; };
struct Gemm { const bf16_t* A; const bf16_t* Bt; int M, N, K, lda; };

struct StaticOrder {
    int nM, nN, nwg, G, c;
    __host__ __device__ void init(int M, int N, int G_, int c_) { nM = M / BM; nN = N / BM; nwg = nM * nN; G = G_; c = c_; }
    __host__ __device__ bool next(int i, Unit& u) const {
        const long L = (long)i * G + c; if (L >= nwg) return false;
        int wgid = (int)L; { const int q = nwg / NXCD, r = nwg % NXCD, xcd = wgid % NXCD, off = wgid / NXCD; wgid = (xcd < r ? xcd * (q + 1) : r * (q + 1) + (xcd - r) * q) + off; }
        const int nig = WGM * nN, gid = wgid / nig, fm = gid * WGM, gsz = (nM - fm) < WGM ? (nM - fm) : WGM;
        u.pm = fm + ((wgid % nig) % gsz); u.pn = (wgid % nig) / gsz; return true;
    }
    __device__ __forceinline__ void a_ready(const Unit&) const {}
    __device__ __forceinline__ void done(const Unit&) const {}
};

__device__ __forceinline__ unsigned cvt_pk_bf16(float lo, float hi) { unsigned r; asm volatile("v_cvt_pk_bf16_f32 %0, %1, %2" : "=v"(r) : "v"(lo), "v"(hi)); return r; }
typedef float f32x2 __attribute__((ext_vector_type(2)));
__device__ __forceinline__ float bf_lo(unsigned w) { return __builtin_bit_cast(float, w << 16); }
__device__ __forceinline__ float bf_hi(unsigned w) { return __builtin_bit_cast(float, w & 0xffff0000u); }
__device__ __forceinline__ float fast_sigmoid(float x) { return __builtin_amdgcn_rcpf(1.0f + __expf(-x)); }
constexpr float RMS_EPS = 1e-6f;
struct EpiScaleBf16 {
    static constexpr bool PERM = true, AFTER_DRAIN = false;
    bf16_t* O; int ldc; const float* ss;
    __device__ __forceinline__ void operator()(const f32x4 (&acc)[2][2][4][2], const Unit& u, int wr, int wc, int fr, int fq) const {
        const int row0 = u.pm * BM + wr * 64 + fr, col0 = u.pn * BM + wc * 32 + 8 * fq;
#pragma unroll
        for (int ai = 0; ai < 2; ++ai)
#pragma unroll
            for (int m = 0; m < 4; ++m) { const int row = row0 + ai * HALF + m * 16; const float rs = ss ? 1.0f / sqrtf(ss[row] * (1.0f / 1024.0f) + RMS_EPS) : 1.0f;
                bf16_t* rowp = O + (size_t)row * ldc + col0;
#pragma unroll
                for (int bj = 0; bj < 2; ++bj) { const f32x4 v0 = acc[ai][bj][m][0] * rs, v1 = acc[ai][bj][m][1] * rs;
                    u32x4 w; w.x = cvt_pk_bf16(v0[0], v0[1]); w.y = cvt_pk_bf16(v0[2], v0[3]); w.z = cvt_pk_bf16(v1[0], v1[1]); w.w = cvt_pk_bf16(v1[2], v1[3]);
                    *(u32x4*)(rowp + bj * HALF) = w; } }
    }
};
struct EpiGlu {
    static constexpr bool PERM = true, AFTER_DRAIN = false;
    const bf16_t* Y; bf16_t* O; int ldc, ocol;
    __device__ __forceinline__ void operator()(const f32x4 (&acc)[2][2][4][2], const Unit& u, int wr, int wc, int fr, int fq) const {
        const int row0 = u.pm * BM + wr * 64 + fr, col0 = u.pn * BM + wc * 32 + 8 * fq;
#pragma unroll
        for (int ai = 0; ai < 2; ++ai)
#pragma unroll
            for (int m = 0; m < 4; ++m) { const int row = row0 + ai * HALF + m * 16;
#pragma unroll
                for (int bj = 0; bj < 2; ++bj) { const u32x4 yv = *(const u32x4*)(Y + (size_t)row * 256 + col0 + bj * HALF);
                    const f32x4 a0 = acc[ai][bj][m][0], a1 = acc[ai][bj][m][1];
                    u32x4 w;
                    w.x = cvt_pk_bf16(bf_lo(yv.x) * fast_sigmoid(a0[0]), bf_hi(yv.x) * fast_sigmoid(a0[1]));
                    w.y = cvt_pk_bf16(bf_lo(yv.y) * fast_sigmoid(a0[2]), bf_hi(yv.y) * fast_sigmoid(a0[3]));
                    w.z = cvt_pk_bf16(bf_lo(yv.z) * fast_sigmoid(a1[0]), bf_hi(yv.z) * fast_sigmoid(a1[1]));
                    w.w = cvt_pk_bf16(bf_lo(yv.w) * fast_sigmoid(a1[2]), bf_hi(yv.w) * fast_sigmoid(a1[3]));
                    *(u32x4*)(O + (size_t)row * ldc + ocol + col0 + bj * HALF) = w; }
                if (m & 1) asm volatile("" ::: "memory"); }
    }
};
struct EpiResid {
    static constexpr bool PERM = false, AFTER_DRAIN = false;
    const float* resid; float* out; bf16_t* xb; float* ss;
    __device__ __forceinline__ void operator()(const f32x4 (&acc)[2][2][4][2], const Unit& u, int wr, int wc, int fr, int fq) const {
        typedef unsigned u32x2v __attribute__((ext_vector_type(2)));
        const int row0 = u.pm * BM + wr * 64 + fr, col0 = u.pn * BM + wc * 32 + 4 * fq;
#pragma unroll
        for (int ai = 0; ai < 2; ++ai)
#pragma unroll
            for (int m = 0; m < 4; ++m) { const int row = row0 + ai * HALF + m * 16; const size_t off = (size_t)row * 1024 + col0; float s = 0.f;
#pragma unroll
                for (int bj = 0; bj < 2; ++bj)
#pragma unroll
                    for (int n = 0; n < 2; ++n) { const f32x4 r = *(const f32x4*)(resid + off + bj * HALF + n * 16); const f32x4 v = r + acc[ai][bj][m][n];
                        *(f32x4*)(out + off + bj * HALF + n * 16) = v; s += (v[0] * v[0] + v[1] * v[1]) + (v[2] * v[2] + v[3] * v[3]);
                        u32x2v w; w.x = cvt_pk_bf16(v[0], v[1]); w.y = cvt_pk_bf16(v[2], v[3]); *(u32x2v*)(xb + off + bj * HALF + n * 16) = w; }
                s += __shfl_xor(s, 16); s += __shfl_xor(s, 32);
                if (fq == 0) __hip_atomic_fetch_add(ss + row, s, __ATOMIC_RELAXED, __HIP_MEMORY_SCOPE_AGENT); }
    }
};
struct EpiSwiglu {
    static constexpr bool PERM = true, AFTER_DRAIN = false;
    bf16_t* O; int ldc; const float* ss;
    __device__ __forceinline__ void operator()(const f32x4 (&acc)[2][2][4][2], const Unit& u, int wr, int wc, int fr, int fq) const {
        const int row0 = u.pm * BM + wr * 64 + fr, col0 = u.pn * HALF + wc * 32 + 8 * fq;
#pragma unroll
        for (int ai = 0; ai < 2; ++ai)
#pragma unroll
            for (int m = 0; m < 4; ++m) { const int row = row0 + ai * HALF + m * 16; const float rs = 1.0f / sqrtf(ss[row] * (1.0f / 1024.0f) + RMS_EPS);
                float o[8];
#pragma unroll
                for (int n = 0; n < 2; ++n)
#pragma unroll
                    for (int j = 0; j < 4; ++j) { const float g = acc[ai][0][m][n][j] * rs, up = acc[ai][1][m][n][j] * rs; o[n * 4 + j] = g * fast_sigmoid(g) * up; }
                u32x4 w; w.x = cvt_pk_bf16(o[0], o[1]); w.y = cvt_pk_bf16(o[2], o[3]); w.z = cvt_pk_bf16(o[4], o[5]); w.w = cvt_pk_bf16(o[6], o[7]);
                *(u32x4*)(O + (size_t)row * ldc + col0) = w; }
    }
};

template <class Epi, class Sched, bool ALIGN_EPI = false, bool SP2 = false>
__device__ __forceinline__ void gemm_phase(PG8_LAS unsigned char* lds, const Gemm g, const Sched& S, const Epi& E) {
    int tid_ = threadIdx.x; asm volatile("" : "+v"(tid_));
    const int tid = tid_, wid = __builtin_amdgcn_readfirstlane(tid >> 6), lane = tid & 63, wr = wid >> 2, wc = wid & 3, fr = lane & 15, fq = lane >> 4;
    const int K = g.K, nt = K / BK, lda = g.lda;
    unsigned voffA[2], voffB[2];
#pragma unroll
    for (int i = 0; i < 2; ++i) { int R, C; stage_rc(tid * 16 + i * 8192, R, C); const int Rb = Epi::PERM ? ((R & ~31) + perm32(R & 31)) : R;
        voffA[i] = (unsigned)(R * lda + C) * 2u; voffB[i] = (unsigned)(Rb * K + C) * 2u; }
    const size_t kstep = (size_t)(BK * 2);
    const size_t hstep = (size_t)HALF * K * 2;
    const size_t tstep = 2 * hstep; const size_t hstepA = (size_t)HALF * lda * 2, tstepA = 2 * hstepA;
    const unsigned ldsw = (unsigned)wid * 1024u;
    const int aoff = lds_byte(wr * 64 + fr, fq * 8), boff = lds_byte(wc * 32 + fr, fq * 8);
#define PG8_SA(b, h) (((b) * 2 + (h)) * HTB)
#define PG8_SB(b, h) ((4 + (b) * 2 + (h)) * HTB)
#define PG8_STAGE(bufoff, gbase, voff) do { _Pragma("unroll") for (int _i = 0; _i < 2; ++_i) \
        __builtin_amdgcn_global_load_lds((const unsigned*)((const char*)(gbase) + (voff)[_i]), (PG8_LAS unsigned*)(lds + (bufoff) + ldsw + _i * 8192), 16, 0, 0); } while (0)
#define PG8_LDA(dst, b, h) do { _Pragma("unroll") for (int m = 0; m < 4; ++m) _Pragma("unroll") for (int k = 0; k < 2; ++k) dst[m][k] = *(const PG8_LAS bf16x8*)(lds + PG8_SA(b, h) + aoff + m * 2048 + k * 1024); } while (0)
#define PG8_LDB(dst, b, h) do { _Pragma("unroll") for (int n = 0; n < 2; ++n) _Pragma("unroll") for (int k = 0; k < 2; ++k) dst[n][k] = *(const PG8_LAS bf16x8*)(lds + PG8_SB(b, h) + boff + n * 2048 + k * 1024); } while (0)
#define PG8_MMA(ai, bj, At, Bt) do { __builtin_amdgcn_s_setprio(1); _Pragma("unroll") for (int m = 0; m < 4; ++m) _Pragma("unroll") for (int n = 0; n < 2; ++n) _Pragma("unroll") for (int k = 0; k < 2; ++k) \
        acc[ai][bj][m][n] = __builtin_amdgcn_mfma_f32_16x16x32_bf16(Bt[n][k], At[m][k], acc[ai][bj][m][n], 0, 0, 0); __builtin_amdgcn_s_setprio(0); } while (0)
#define PG8_WAIT_V(n) asm volatile("s_waitcnt vmcnt(" #n ")" ::: "memory")
#define PG8_WAIT_L(n) asm volatile("s_waitcnt lgkmcnt(" #n ")" ::: "memory")
#define PG8_BAR __builtin_amdgcn_s_barrier()
#define PG8_SCHED __builtin_amdgcn_sched_barrier(0)
    Unit cur, nxt; int ui = 0;
    if (!S.next(0, cur)) return;
    f32x4 acc[2][2][4][2];
#pragma unroll
    for (int a = 0; a < 2; ++a)
#pragma unroll
        for (int b = 0; b < 2; ++b)
#pragma unroll
            for (int m = 0; m < 4; ++m)
#pragma unroll
                for (int n = 0; n < 2; ++n) acc[a][b][m][n] = (f32x4){0.f, 0.f, 0.f, 0.f};
    bf16x8 At[4][2], B0[2][2], B1[2][2];
    const char* cA = (const char*)g.A + (size_t)cur.pm * tstepA; const char* cB = (const char*)g.Bt + (size_t)cur.pn * tstep;
    S.a_ready(cur);
    if constexpr (SP2) {
        PG8_STAGE(PG8_SB(0, 0), cB, voffB); PG8_STAGE(PG8_SB(0, 1), cB + hstep, voffB); PG8_STAGE(PG8_SA(0, 0), cA, voffA); PG8_STAGE(PG8_SA(0, 1), cA + hstepA, voffA);
        if (wr == 1) PG8_BAR;
        PG8_WAIT_V(2); PG8_BAR;
        PG8_STAGE(PG8_SB(1, 0), cB + kstep, voffB); PG8_STAGE(PG8_SA(1, 0), cA + kstep, voffA); PG8_STAGE(PG8_SB(1, 1), cB + hstep + kstep, voffB);
        PG8_WAIT_V(6); PG8_BAR;
    } else {
        PG8_STAGE(PG8_SB(0, 0), cB, voffB); PG8_STAGE(PG8_SA(0, 0), cA, voffA); PG8_STAGE(PG8_SB(0, 1), cB + hstep, voffB); PG8_STAGE(PG8_SA(0, 1), cA + hstepA, voffA);
        if (wr == 1) PG8_BAR;
        PG8_WAIT_V(4); PG8_BAR;
        PG8_STAGE(PG8_SB(1, 0), cB + kstep, voffB); PG8_STAGE(PG8_SA(1, 0), cA + kstep, voffA); PG8_STAGE(PG8_SB(1, 1), cB + hstep + kstep, voffB);
        PG8_WAIT_V(6); PG8_BAR;
    }
    for (;;) {
        const bool has_next = S.next(ui + 1, nxt);
        const char* nA = has_next ? (const char*)g.A + (size_t)nxt.pm * tstepA : cA; const char* nB = has_next ? (const char*)g.Bt + (size_t)nxt.pn * tstep : cB;
        for (int t = 0; t < nt; t += 2) {
            const bool last = (t == nt - 2);
            const char* a1 = cA + (size_t)(t + 1) * kstep;
            const char* a2 = last ? nA : cA + (size_t)(t + 2) * kstep; const char* b2 = last ? nB : cB + (size_t)(t + 2) * kstep;
            const char* a3 = a2 + kstep; const char* b3 = b2 + kstep;
            if (last && has_next) S.a_ready(nxt);
            if constexpr (SP2) {
            PG8_LDB(B0, 0, 0); PG8_LDB(B1, 0, 1); PG8_SCHED; PG8_LDA(At, 0, 0); PG8_STAGE(PG8_SA(1, 1), a1 + hstepA, voffA);
            PG8_WAIT_V(8); PG8_WAIT_L(0); PG8_BAR; PG8_MMA(0, 0, At, B0); PG8_MMA(0, 1, At, B1); PG8_BAR; PG8_SCHED;
            PG8_LDA(At, 0, 1); PG8_STAGE(PG8_SB(0, 0), b2, voffB); PG8_STAGE(PG8_SB(0, 1), b2 + hstep, voffB); PG8_STAGE(PG8_SA(0, 0), a2, voffA);
            PG8_WAIT_V(8); PG8_WAIT_L(0); PG8_BAR; PG8_MMA(1, 0, At, B0); PG8_MMA(1, 1, At, B1); PG8_BAR; PG8_SCHED;
            PG8_LDB(B0, 1, 0); PG8_LDB(B1, 1, 1); PG8_SCHED; PG8_LDA(At, 1, 0); PG8_STAGE(PG8_SA(0, 1), a2 + hstepA, voffA);
            PG8_WAIT_V(8); PG8_WAIT_L(0); PG8_BAR; PG8_MMA(0, 0, At, B0); PG8_MMA(0, 1, At, B1); PG8_BAR; PG8_SCHED;
            PG8_LDA(At, 1, 1); PG8_STAGE(PG8_SB(1, 0), b3, voffB); PG8_STAGE(PG8_SB(1, 1), b3 + hstep, voffB); PG8_STAGE(PG8_SA(1, 0), a3, voffA);
            PG8_WAIT_V(8); PG8_WAIT_L(0); PG8_BAR; PG8_MMA(1, 0, At, B0); PG8_MMA(1, 1, At, B1); PG8_BAR; PG8_SCHED;
            } else {
            PG8_LDB(B0, 0, 0); PG8_SCHED; PG8_LDA(At, 0, 0); PG8_STAGE(PG8_SA(1, 1), a1 + hstepA, voffA);
            PG8_WAIT_L(8); PG8_BAR; PG8_WAIT_L(0); PG8_MMA(0, 0, At, B0); PG8_BAR; PG8_SCHED;
            PG8_LDB(B1, 0, 1); PG8_STAGE(PG8_SB(0, 0), b2, voffB);
            PG8_BAR; PG8_WAIT_L(0); PG8_MMA(0, 1, At, B1); PG8_BAR;
            PG8_LDA(At, 0, 1); PG8_STAGE(PG8_SA(0, 0), a2, voffA);
            PG8_BAR; PG8_WAIT_L(0); PG8_MMA(1, 0, At, B0); PG8_BAR; PG8_SCHED;
            PG8_STAGE(PG8_SB(0, 1), b2 + hstep, voffB);
            PG8_WAIT_V(6); PG8_BAR; PG8_MMA(1, 1, At, B1); PG8_BAR;
            PG8_LDB(B0, 1, 0); PG8_SCHED; PG8_LDA(At, 1, 0); PG8_STAGE(PG8_SA(0, 1), a2 + hstepA, voffA);
            PG8_WAIT_L(8); PG8_BAR; PG8_WAIT_L(0); PG8_MMA(0, 0, At, B0); PG8_BAR; PG8_SCHED;
            PG8_LDB(B1, 1, 1); PG8_STAGE(PG8_SB(1, 0), b3, voffB);
            PG8_BAR; PG8_WAIT_L(0); PG8_MMA(0, 1, At, B1); PG8_BAR;
            PG8_LDA(At, 1, 1); PG8_STAGE(PG8_SA(1, 0), a3, voffA);
            PG8_BAR; PG8_WAIT_L(0); PG8_MMA(1, 0, At, B0); PG8_BAR; PG8_SCHED;
            PG8_STAGE(PG8_SB(1, 1), b3 + hstep, voffB);
            PG8_WAIT_V(6); PG8_BAR; PG8_MMA(1, 1, At, B1); PG8_BAR;
            }
        }
        if constexpr (ALIGN_EPI) { if (wr == 0) PG8_BAR; }
        if constexpr (!Epi::AFTER_DRAIN) { E(acc, cur, wr, wc, fr, fq); S.done(cur); }
        if (!has_next) break;
#pragma unroll
        for (int a = 0; a < 2; ++a)
#pragma unroll
            for (int b = 0; b < 2; ++b)
#pragma unroll
                for (int m = 0; m < 4; ++m)
#pragma unroll
                    for (int n = 0; n < 2; ++n) acc[a][b][m][n] = (f32x4){0.f, 0.f, 0.f, 0.f};
        cur = nxt; cA = nA; cB = nB; ++ui;
        if constexpr (ALIGN_EPI) { if (wr == 1) PG8_BAR; }
    }
    PG8_WAIT_V(0);
    if constexpr (!ALIGN_EPI) { if (wr == 0) PG8_BAR; }
    PG8_BAR;
    if constexpr (Epi::AFTER_DRAIN) { E.fused(acc, cur, wr, wc, fr, fq, lds, wid, lane); S.done(cur); }
#undef PG8_SA
#undef PG8_SB
#undef PG8_STAGE
#undef PG8_LDA
#undef PG8_LDB
#undef PG8_MMA
#undef PG8_WAIT_V
#undef PG8_WAIT_L
#undef PG8_BAR
#undef PG8_SCHED
}
}
constexpr int NB = 16, SEQ = 2048, D = 1024, T = NB * SEQ, DIN = 2304, DFF = 2816, DEPTH = 2;
constexpr int NWAVES = 8;
constexpr int PC_Q = 0, PC_F = 256, PC_I = 512, PC_G = 768, PC_U = 1024, PC_MX = 1280, PC_MZ = 1792;
constexpr float EPS = 1e-6f;
constexpr int NPHASE = 20;
#ifndef MK_ONE_LAUNCH
#define MK_ONE_LAUNCH 0
#endif

constexpr size_t MiB = 1u << 20;
constexpr size_t WS_CTL = 0, CTL_ZERO_BYTES = 1 * MiB;
constexpr size_t WS_PAR = 1 * MiB;
constexpr size_t WS_SS0 = 2 * MiB;
constexpr size_t WS_GATES = 3 * MiB;
constexpr size_t WS_WIN = 4 * MiB, WIN_STRIDE = 6 * MiB;
constexpr size_t WS_WOUT = 16 * MiB, WOUT_STRIDE = 2 * MiB;
constexpr size_t WS_WGU = 20 * MiB, WGU_STRIDE = 11 * MiB;
constexpr size_t WS_WD = 42 * MiB, WD_STRIDE = 6 * MiB;
constexpr size_t WS_WQK = 54 * MiB, WQK_STRIDE = 1 * MiB;
constexpr size_t WS_WV = 56 * MiB, WV_STRIDE = MiB / 2;
constexpr size_t WS_WGLU = 57 * MiB, WGLU_STRIDE = MiB / 8;
constexpr size_t WS_XB = 64 * MiB;
constexpr size_t WS_P = 128 * MiB;
constexpr size_t WS_MID = 128 * MiB;
constexpr size_t WS_XC = 272 * MiB;
constexpr size_t WS_QKV = 304 * MiB;
constexpr size_t WS_MIX = 400 * MiB;
constexpr size_t WS_YS5 = 464 * MiB;
constexpr size_t WS_END = 480 * MiB;
static_assert(WS_MID + (size_t)T * DFF * 2 <= WS_QKV && WS_P + (size_t)T * DIN * 2 <= WS_XC, "d_ws map");
constexpr int CW_TMO = 0, CW_CODE = 1, CW_BAR = 4096;
constexpr size_t CTL_SS_OFF = 256 * 1024;
constexpr int PAR_LBV = 0, PAR_S5A = 1024, PAR_S5BB = 8192;

constexpr int RING_OFF = 0, RING_BYTES = 131072;
constexpr int LDSCTL_OFF = RING_BYTES, MISC_OFF = LDSCTL_OFF + 320;
constexpr int LDS_BYTES = 147456;

#define GAS __attribute__((address_space(1)))
#define LAS __attribute__((address_space(3)))
typedef unsigned short bf16;
typedef unsigned v4u __attribute__((ext_vector_type(4)));
typedef float f32x4 __attribute__((ext_vector_type(4)));
typedef short bf16x8 __attribute__((ext_vector_type(8)));
typedef GAS unsigned gu32;
typedef GAS unsigned long long gu64;
#define RLX_AGENT __ATOMIC_RELAXED, __HIP_MEMORY_SCOPE_AGENT
#define LDS_WAIT() asm volatile("s_waitcnt lgkmcnt(0)" ::: "memory")
#define VM_WAIT() asm volatile("s_waitcnt vmcnt(0)" ::: "memory")
__device__ __forceinline__ unsigned long long rt() { return __builtin_amdgcn_s_memrealtime(); }
__device__ __forceinline__ unsigned f2bf(float f) { unsigned u = __builtin_bit_cast(unsigned, f); return (u + 0x7fffu + ((u >> 16) & 1u)) >> 16; }
__device__ __forceinline__ unsigned pk2(float lo, float hi) { return f2bf(lo) | (f2bf(hi) << 16); }
#define XB_TMO      128
#define XB_XCNT(j)  (256  + 64 * (j))
#define XB_XSUB(j)  (1280 + 64 * (j))
#define XB_XGEN(j)  (2304 + 64 * (j))
#define XB_TOP      3328
#define XB_TOPGEN   3392
#define XCD_BAR_WORDS 3456
#define XB_SPIN_CAP (1u << 18)

__device__ __forceinline__ unsigned xb_ld(unsigned* p)              { return __hip_atomic_load(p, __ATOMIC_RELAXED, __HIP_MEMORY_SCOPE_AGENT); }
__device__ __forceinline__ unsigned xb_add(unsigned* p, unsigned v) { return __hip_atomic_fetch_add(p, v, __ATOMIC_RELAXED, __HIP_MEMORY_SCOPE_AGENT); }
__device__ __forceinline__ unsigned xb_xcc_id() { return (unsigned)__builtin_amdgcn_s_getreg((3 << 11) | 20) & 0xFu; }
#define XB_SPIN(cond, bar) do { unsigned _sp = 0; while (cond) { __builtin_amdgcn_s_sleep(1); \
    if ((++_sp & 255u) == 0u) { if (xb_ld(&(bar)[XB_TMO])) break; if (_sp > XB_SPIN_CAP) { atomicAdd(&(bar)[XB_TMO], 1u); break; } } } } while (0)

struct XcdBarrier {
    unsigned* bar; unsigned x;
    volatile LAS unsigned* st;
};

__device__ __forceinline__ XcdBarrier xcd_barrier_post(unsigned* bar, volatile LAS unsigned* st) {
    XcdBarrier b; b.bar = bar; b.x = xb_xcc_id(); b.st = st;
    if (threadIdx.x == 0) (void)xb_add(&bar[XB_XCNT(b.x)], 1u);
    return b;
}
__device__ __forceinline__ void xcd_barrier_complete(unsigned* bar, unsigned x, unsigned& nloc, unsigned& nx) {
    const unsigned G = gridDim.x * gridDim.y * gridDim.z;
    unsigned sum, cnt, mine, sp = 0u;
    for (;;) {
        sum = 0u; cnt = 0u; mine = 0u;
#pragma unroll
        for (unsigned j = 0; j < 16; ++j) { const unsigned c = xb_ld(&bar[XB_XCNT(j)]); sum += c; cnt += (c > 0u) ? 1u : 0u; mine = (j == x) ? c : mine; }
        if (sum == G) break;
        __builtin_amdgcn_s_sleep(1);
        if ((++sp & 255u) == 0u) { if (xb_ld(&bar[XB_TMO])) break; if (sp > XB_SPIN_CAP) { atomicAdd(&bar[XB_TMO], 1u); break; } }
    }
    nloc = mine > 0u ? mine : 1u; nx = cnt > 0u ? cnt : 1u;
}

__device__ __forceinline__ void xcd_barrier(const XcdBarrier& b) {
    asm volatile("s_waitcnt vmcnt(0)" ::: "memory");
    __syncthreads();
    if (threadIdx.x == 0) {
        unsigned* bar = b.bar;
        __builtin_amdgcn_s_waitcnt(0);
        unsigned nloc = b.st[0], nx = b.st[1];
        if (nloc == 0u) { xcd_barrier_complete(bar, b.x, nloc, nx); b.st[0] = nloc; b.st[1] = nx; }
        const unsigned old = xb_add(&bar[XB_XSUB(b.x)], 1u);
        const unsigned gen = old / nloc;
        if (old + 1u == (gen + 1u) * nloc) {
            __builtin_amdgcn_fence(__ATOMIC_RELEASE, "agent");
            asm volatile("s_waitcnt vmcnt(0)" ::: "memory");
            const unsigned og = xb_add(&bar[XB_TOP], 1u);
            const unsigned tg = og / nx;
            if (og + 1u == (tg + 1u) * nx) xb_add(&bar[XB_TOPGEN], 1u);
            else XB_SPIN(xb_ld(&bar[XB_TOPGEN]) == tg, bar);
            __builtin_amdgcn_fence(__ATOMIC_ACQUIRE, "agent");
            xb_add(&bar[XB_XGEN(b.x)], 1u);
            asm volatile("s_waitcnt vmcnt(0)" ::: "memory");
        } else {
            XB_SPIN(xb_ld(&bar[XB_XGEN(b.x)]) == gen, bar);
            __builtin_amdgcn_fence(__ATOMIC_ACQUIRE, "agent");
            asm volatile("s_waitcnt vmcnt(0)" ::: "memory");
        }
    }
    __syncthreads();
}
struct Frame {
    LAS unsigned char* lds;
    volatile LAS unsigned* MISC;
    gu32* ctl;
    int vcu, G;
    const float* const* in;
    float* out;
    unsigned char* ws;
    float* par; float* ss0; float* gates;
    bf16 *XB, *P, *MID, *XC, *QKV, *MIX, *YS5;
};
__device__ __forceinline__ float* ss_arr(Frame& F, int i) { return i == 0 ? F.ss0 : (float*)(F.ws + WS_CTL + CTL_SS_OFF) + (size_t)(i - 1) * T; }
__device__ __forceinline__ float bf2f(bf16 v) { return __builtin_bit_cast(float, (unsigned)v << 16); }
__device__ __forceinline__ float sigmoidf_(float x) { return 1.0f / (1.0f + __expf(-x)); }
__device__ __forceinline__ float wave_sum(float v) {
#pragma unroll
    for (int o = 1; o < 64; o <<= 1) v += __shfl_xor(v, o);
    return v;
}
#define LANE_SETUP int tid_ = threadIdx.x; asm volatile("" : "+v"(tid_)); const int tid = tid_, lane = tid & 63, wave = __builtin_amdgcn_readfirstlane(tid >> 6); (void)tid; (void)lane; (void)wave;
__device__ __forceinline__ float gelu_tanh(float y) {
    const float z = 0.7978845608028654f * (y + 0.044715f * y * y * y);
    const float t = 1.0f - 2.0f / (1.0f + __expf(2.0f * z));
    return 0.5f * y * (1.0f + t);
}

__device__ __forceinline__ void p0_transpose_item(const float* W, int K, int N, const float* ksc, bf16* WT, int dst_row0, LAS float* scr, int kb, int nb, int lane) {
    const int k0 = 64 * kb, n0 = 32 * nb;
#pragma unroll 8
    for (int i = 0; i < 32; ++i) { const int kk = 2 * i + (lane >> 5); float v = W[(size_t)(k0 + kk) * N + n0 + (lane & 31)]; if (ksc) v *= ksc[k0 + kk]; scr[kk * 33 + (lane & 31)] = v; }
    LDS_WAIT(); asm volatile("" ::: "memory");
    const int c = lane & 7;
#pragma unroll
    for (int j = 0; j < 4; ++j) { const int n = (lane >> 3) + 8 * j; const LAS float* s = scr + (8 * c) * 33 + n;
        v4u o; o.x = pk2(s[0 * 33], s[1 * 33]); o.y = pk2(s[2 * 33], s[3 * 33]); o.z = pk2(s[4 * 33], s[5 * 33]); o.w = pk2(s[6 * 33], s[7 * 33]);
        *(GAS v4u*)(WT + (size_t)(dst_row0 + n) * K + k0 + 8 * c) = o; }
    LDS_WAIT(); asm volatile("" ::: "memory");
}
__device__ __forceinline__ void p0_prologue(Frame& F) {
    LANE_SETUP
    LAS float* scr = (LAS float*)(F.lds + RING_OFF + wave * 16384);
    const int gw = F.vcu * NWAVES + wave, NGW = F.G * NWAVES;
    constexpr int I_IN = 16 * 72, I_OUT = 16 * 32, I_G = 16 * 88, I_U = I_G, I_D = 44 * 32, I_GLU = 4 * 8, I_LAYER = I_IN + I_OUT + I_G + I_U + I_D + I_GLU;
    for (int it = gw; it < DEPTH * I_LAYER; it += NGW) {
        const int l = it / I_LAYER; int r = it % I_LAYER;
        if (r < I_IN) { const int kb = r / 72, nb = r % 72; p0_transpose_item(F.in[2] + (size_t)l * D * DIN, D, DIN, F.in[1] + l * D, (bf16*)(F.ws + WS_WIN + l * WIN_STRIDE), 32 * nb, scr, kb, nb, lane); continue; } r -= I_IN;
        if (r < I_OUT) { const int kb = r / 32, nb = r % 32; p0_transpose_item(F.in[23] + (size_t)l * D * D, D, D, nullptr, (bf16*)(F.ws + WS_WOUT + l * WOUT_STRIDE), 32 * nb, scr, kb, nb, lane); continue; } r -= I_OUT;
        if (r < I_G) { const int kb = r / 88, nb = r % 88, n0 = 32 * nb; p0_transpose_item(F.in[25] + (size_t)l * D * DFF, D, DFF, F.in[24] + l * D, (bf16*)(F.ws + WS_WGU + l * WGU_STRIDE), 256 * (n0 / 128) + (n0 % 128), scr, kb, nb, lane); continue; } r -= I_G;
        if (r < I_U) { const int kb = r / 88, nb = r % 88, n0 = 32 * nb; p0_transpose_item(F.in[26] + (size_t)l * D * DFF, D, DFF, F.in[24] + l * D, (bf16*)(F.ws + WS_WGU + l * WGU_STRIDE), 256 * (n0 / 128) + 128 + (n0 % 128), scr, kb, nb, lane); continue; } r -= I_U;
        if (r < I_D) { const int kb = r / 32, nb = r % 32; p0_transpose_item(F.in[27] + (size_t)l * DFF * D, DFF, D, nullptr, (bf16*)(F.ws + WS_WD + l * WD_STRIDE), 32 * nb, scr, kb, nb, lane); continue; } r -= I_D;
        { const int kb = r / 8, nb = r % 8; p0_transpose_item(F.in[13] + (size_t)l * 256 * 256, 256, 256, nullptr, (bf16*)(F.ws + WS_WGLU + l * WGLU_STRIDE), 32 * nb, scr, kb, nb, lane); }
    }
    {
        const int gt = (F.vcu * NWAVES + wave) * 64 + lane, NGT = F.G * NWAVES * 64;
        constexpr int PER_L = (1024 * 512 + 512 * 512) / 8;
        for (int it = gt; it < DEPTH * PER_L; it += NGT) {
            const int l = it / PER_L; int r = it % PER_L; const float* src; bf16* dst; float sc = 1.f; int n, k0;
            if (r < 1024 * 512 / 8) { n = r / 64; k0 = (r % 64) * 8; dst = (bf16*)(F.ws + WS_WQK + l * WQK_STRIDE) + (size_t)n * 512 + k0;
                if (n < 512) src = F.in[16]; else { src = F.in[17]; sc = 0.08838834764831845f; } }
            else { r -= 1024 * 512 / 8; n = r / 64; k0 = (r % 64) * 8; dst = (bf16*)(F.ws + WS_WV + l * WV_STRIDE) + (size_t)n * 512 + k0; src = F.in[18]; }
            const int hh = (n & 511) >> 7, e = n & 127;
            v4u o = (v4u){0u, 0u, 0u, 0u};
            if ((k0 >> 7) == hh) { const float* s = src + ((size_t)(l * 4 + hh) * 128 + (k0 & 127)) * 128 + e;
                o.x = pk2(s[0] * sc, s[128] * sc); o.y = pk2(s[256] * sc, s[384] * sc); o.z = pk2(s[512] * sc, s[640] * sc); o.w = pk2(s[768] * sc, s[896] * sc); }
            *(GAS v4u*)dst = o;
        }
        if (gt < 512) { const int c = gt & 255; const float r0 = F.in[3][c], r1 = F.in[3][256 + c], mx = fmaxf(r0, r1), e0 = expf(r0 - mx), e1 = expf(r1 - mx);
            F.par[PAR_LBV + gt] = (gt < 256) ? 0.f : e1 / (e0 + e1); }
        if (gt < DEPTH * 16 * 64) { const int l = gt >> 10, g = (gt >> 6) & 15, p = gt & 63;
            const float lre = F.in[5][gt], lim = F.in[6][gt], dt = expf(F.in[7][l * 16 + g]);
            const float mag = expf(lre * dt), ang = lim * dt; const float ar = mag * cosf(ang), ai = mag * sinf(ang);
            const float den = lre * lre + lim * lim, nr = ar - 1.0f, ni = ai; const float cr = (nr * lre + ni * lim) / den, ci = (ni * lre - nr * lim) / den;
            F.par[PAR_S5A + gt * 2] = ar; F.par[PAR_S5A + gt * 2 + 1] = ai;
            for (int h = 0; h < 16; ++h) { const float br = F.in[8][(size_t)gt * 16 + h], bi = F.in[9][(size_t)gt * 16 + h];
                F.par[PAR_S5BB + gt * 32 + h] = cr * br - ci * bi; F.par[PAR_S5BB + gt * 32 + 16 + h] = cr * bi + ci * br; }
            (void)p; }
    }
    for (int m = gw; m < T; m += NGW) {
        const GAS f32x4* xr = (const GAS f32x4*)(F.in[0] + (size_t)m * D) + lane; GAS unsigned long long* o8 = (GAS unsigned long long*)(F.XB + (size_t)m * D) + lane;
        float s = 0.f;
#pragma unroll
        for (int j = 0; j < 4; ++j) { const f32x4 v = xr[64 * j]; s += (v.x * v.x + v.y * v.y) + (v.z * v.z + v.w * v.w);
            o8[64 * j] = (unsigned long long)pk2(v.x, v.y) | ((unsigned long long)pk2(v.z, v.w) << 32); }
        s = wave_sum(s); if (lane == 0) F.ss0[m] = s;
    }
}

__device__ __forceinline__ void prep_phase(Frame& F, int l) {
    LANE_SETUP
    const int gw = F.vcu * NWAVES + wave, NGW = F.G * NWAVES, c0 = lane * 8;
    const float* cw = F.in[14] + (size_t)l * 4 * 512; const float* cb = F.in[15] + l * 512;
    for (int m = gw; m < T; m += NGW) {
        const int s = m & (SEQ - 1); float a[8];
#pragma unroll
        for (int j = 0; j < 8; ++j) a[j] = cb[c0 + j];
#pragma unroll
        for (int k = 0; k < 4; ++k) { const int sk = s - 3 + k;
            if (sk >= 0) { const v4u w = *(const GAS v4u*)(F.P + (size_t)(m - 3 + k) * DIN + PC_MX + c0); const float* ck = cw + k * 512 + c0;
                a[0] += ck[0] * pg8::bf_lo(w.x); a[1] += ck[1] * pg8::bf_hi(w.x); a[2] += ck[2] * pg8::bf_lo(w.y); a[3] += ck[3] * pg8::bf_hi(w.y);
                a[4] += ck[4] * pg8::bf_lo(w.z); a[5] += ck[5] * pg8::bf_hi(w.z); a[6] += ck[6] * pg8::bf_lo(w.w); a[7] += ck[7] * pg8::bf_hi(w.w); } }
#pragma unroll
        for (int j = 0; j < 8; ++j) a[j] = a[j] * sigmoidf_(a[j]);
        v4u o; o.x = pk2(a[0], a[1]); o.y = pk2(a[2], a[3]); o.z = pk2(a[4], a[5]); o.w = pk2(a[6], a[7]);
        *(GAS v4u*)(F.XC + (size_t)m * 512 + c0) = o;
    }
}
__device__ __forceinline__ void gates_phase(Frame& F, int l) {
    LANE_SETUP
    const int gw = F.vcu * NWAVES + wave, NGW = F.G * NWAVES;
    const float* wg = F.in[19] + (size_t)l * 1536 * 8; const float* bg = F.in[20] + l * 8;
    for (int m = gw; m < T; m += NGW) {
        float acc[8];
#pragma unroll
        for (int j = 0; j < 8; ++j) acc[j] = 0.f;
#pragma unroll
        for (int seg = 0; seg < 3; ++seg) { const int cbase = seg * 512 + lane * 8; const v4u w = *(const GAS v4u*)(F.QKV + (size_t)m * 1536 + cbase);
            float x[8]; x[0] = pg8::bf_lo(w.x); x[1] = pg8::bf_hi(w.x); x[2] = pg8::bf_lo(w.y); x[3] = pg8::bf_hi(w.y); x[4] = pg8::bf_lo(w.z); x[5] = pg8::bf_hi(w.z); x[6] = pg8::bf_lo(w.w); x[7] = pg8::bf_hi(w.w);
#pragma unroll
            for (int i = 0; i < 8; ++i) { const f32x4 wa = *(const GAS f32x4*)(wg + (size_t)(cbase + i) * 8), wb = *(const GAS f32x4*)(wg + (size_t)(cbase + i) * 8 + 4);
                acc[0] += x[i] * wa.x; acc[1] += x[i] * wa.y; acc[2] += x[i] * wa.z; acc[3] += x[i] * wa.w; acc[4] += x[i] * wb.x; acc[5] += x[i] * wb.y; acc[6] += x[i] * wb.z; acc[7] += x[i] * wb.w; } }
#pragma unroll
        for (int j = 0; j < 8; ++j) acc[j] = wave_sum(acc[j]);
        if (lane < 8) { float v = acc[0];
#pragma unroll
            for (int j = 1; j < 8; ++j) v = (lane == j) ? acc[j] : v;
            F.gates[(size_t)m * 8 + lane] = v + bg[lane]; }
    }
}
__device__ __forceinline__ void final_phase(Frame& F) {
    LANE_SETUP
    const int gw = F.vcu * NWAVES + wave, NGW = F.G * NWAVES; const float* ss = ss_arr(F, 4); const float* g = F.in[28];
    f32x4 gv[4];
#pragma unroll
    for (int j = 0; j < 4; ++j) gv[j] = *(const GAS f32x4*)(g + 256 * j + lane * 4);
    for (int m = gw; m < T; m += NGW) { const float rs = 1.0f / sqrtf(ss[m] * (1.0f / 1024.0f) + EPS);
        GAS f32x4* xr = (GAS f32x4*)(F.out + (size_t)m * D) + lane;
#pragma unroll
        for (int j = 0; j < 4; ++j) { f32x4 v = xr[64 * j]; v = v * rs * gv[j]; xr[64 * j] = v; } }
}

__device__ __forceinline__ void hgrn_naive(Frame& F, int l, int item, LAS float* scr) {
    LANE_SETUP const int b = item >> 2, h = item & 3, c = h * 64 + lane;
    const float lb = F.par[PAR_LBV + l * 256 + c], omlb = 1.0f - lb, ng = F.in[4][l * 256 + c];
    float S[64];
#pragma unroll
    for (int d = 0; d < 64; ++d) S[d] = 0.f;
    const bf16* Pb = F.P + (size_t)(b * SEQ) * DIN + c;
    LAS float *qs = scr, *fs = scr + 512, *ks = scr + 1024, *is = scr + 1536, *gs = scr + 2048;
    for (int t0 = 0; t0 < SEQ; t0 += 8) {
#pragma unroll
        for (int j = 0; j < 8; ++j) { const bf16* pr = Pb + (size_t)(t0 + j) * DIN;
            const float qr = bf2f(pr[PC_Q]), fr = bf2f(pr[PC_F]), ir = bf2f(pr[PC_I]), gr = bf2f(pr[PC_G]); const float sg = sigmoidf_(fr);
            qs[j * 64 + lane] = qr * sigmoidf_(qr); fs[j * 64 + lane] = lb + omlb * sg; ks[j * 64 + lane] = omlb * (1.0f - sg); is[j * 64 + lane] = ir; gs[j * 64 + lane] = gr * sigmoidf_(gr); }
        LDS_WAIT(); __builtin_amdgcn_wave_barrier();
        for (int j = 0; j < 8; ++j) {
            const float iv = is[j * 64 + lane]; float o = 0.f;
#pragma unroll
            for (int d4 = 0; d4 < 16; ++d4) { const f32x4 f4 = *(const LAS f32x4*)(fs + j * 64 + d4 * 4), k4 = *(const LAS f32x4*)(ks + j * 64 + d4 * 4), q4 = *(const LAS f32x4*)(qs + j * 64 + d4 * 4);
                S[4 * d4 + 0] = f4.x * S[4 * d4 + 0] + k4.x * iv; o += S[4 * d4 + 0] * q4.x;
                S[4 * d4 + 1] = f4.y * S[4 * d4 + 1] + k4.y * iv; o += S[4 * d4 + 1] * q4.y;
                S[4 * d4 + 2] = f4.z * S[4 * d4 + 2] + k4.z * iv; o += S[4 * d4 + 2] * q4.z;
                S[4 * d4 + 3] = f4.w * S[4 * d4 + 3] + k4.w * iv; o += S[4 * d4 + 3] * q4.w; }
            const float ms = wave_sum(o * o) * (1.0f / 64.0f);
            const float val = o * (1.0f / sqrtf(ms + EPS)) * ng * gs[j * 64 + lane];
            F.MIX[(size_t)(b * SEQ + t0 + j) * 1024 + c] = (bf16)f2bf(val);
        }
        LDS_WAIT(); __builtin_amdgcn_wave_barrier();
    }
}
__device__ __forceinline__ void s5_naive(Frame& F, int l, int item, LAS float* scr) {
    LANE_SETUP const int b = item >> 4, g = item & 15, lg = l * 16 + g;
    LAS float *cre = scr, *cim = scr + 16 * 65, *xs = scr + 2 * 16 * 65;
    for (int h = 0; h < 16; ++h) { cre[h * 65 + lane] = F.in[10][((size_t)lg * 16 + h) * 64 + lane]; cim[h * 65 + lane] = F.in[11][((size_t)lg * 16 + h) * 64 + lane]; }
    const float ar = F.par[PAR_S5A + (lg * 64 + lane) * 2], ai = F.par[PAR_S5A + (lg * 64 + lane) * 2 + 1];
    float bbr[16], bbi[16];
#pragma unroll
    for (int h = 0; h < 16; ++h) { bbr[h] = F.par[PAR_S5BB + (lg * 64 + lane) * 32 + h]; bbi[h] = F.par[PAR_S5BB + (lg * 64 + lane) * 32 + 16 + h]; }
    const int hh = lane & 15, tq = lane >> 4; const float dd = F.in[12][l * 256 + g * 16 + hh];
    float xr = 0.f, xi = 0.f;
    const bf16* Ub = F.P + (size_t)(b * SEQ) * DIN + PC_U + g * 16;
    LDS_WAIT(); __builtin_amdgcn_wave_barrier();
    for (int t0 = 0; t0 < SEQ; t0 += 8) {
#pragma unroll 2
        for (int j = 0; j < 8; ++j) { const GAS v4u* up = (const GAS v4u*)(Ub + (size_t)(t0 + j) * DIN); const v4u w0 = up[0], w1 = up[1];
            float u[16]; u[0] = pg8::bf_lo(w0.x); u[1] = pg8::bf_hi(w0.x); u[2] = pg8::bf_lo(w0.y); u[3] = pg8::bf_hi(w0.y); u[4] = pg8::bf_lo(w0.z); u[5] = pg8::bf_hi(w0.z); u[6] = pg8::bf_lo(w0.w); u[7] = pg8::bf_hi(w0.w);
            u[8] = pg8::bf_lo(w1.x); u[9] = pg8::bf_hi(w1.x); u[10] = pg8::bf_lo(w1.y); u[11] = pg8::bf_hi(w1.y); u[12] = pg8::bf_lo(w1.z); u[13] = pg8::bf_hi(w1.z); u[14] = pg8::bf_lo(w1.w); u[15] = pg8::bf_hi(w1.w);
            float bur = 0.f, bui = 0.f;
#pragma unroll
            for (int h = 0; h < 16; ++h) { bur += bbr[h] * u[h]; bui += bbi[h] * u[h]; }
            const float nxr = ar * xr - ai * xi + bur, nxi = ar * xi + ai * xr + bui; xr = nxr; xi = nxi;
            xs[(j * 2 + 0) * 64 + lane] = xr; xs[(j * 2 + 1) * 64 + lane] = xi; }
        LDS_WAIT(); __builtin_amdgcn_wave_barrier();
#pragma unroll
        for (int jj = 0; jj < 2; ++jj) { const int j = tq + 4 * jj; float y = 0.f;
            for (int p = 0; p < 64; ++p) y += cre[hh * 65 + p] * xs[(j * 2) * 64 + p] - cim[hh * 65 + p] * xs[(j * 2 + 1) * 64 + p];
            const size_t row = (size_t)(b * SEQ + t0 + j);
            y += dd * bf2f(Ub[(size_t)(t0 + j) * DIN + hh]);
            F.YS5[row * 256 + g * 16 + hh] = (bf16)f2bf(gelu_tanh(y)); }
        LDS_WAIT(); __builtin_amdgcn_wave_barrier();
    }
}
__device__ __forceinline__ void mlstm_naive(Frame& F, int l, int item) {
    LANE_SETUP const int b = item >> 2, h = item & 3, w = wave;
    LAS float *qs = (LAS float*)F.lds, *ks = qs + 2048, *vs = ks + 2048, *hs = vs + 2048, *fi = hs + 2048;
    const int e = w * 16 + (lane & 15), dq = lane >> 4;
    float C[32];
#pragma unroll
    for (int i = 0; i < 32; ++i) C[i] = 0.f;
    float n0 = 0.f, n1 = 0.f;
    const bf16* Qb = F.QKV + (size_t)(b * SEQ) * 1536 + h * 128;
    const float* ngp = F.in[21] + l * 512 + h * 128; const float* skp = F.in[22] + l * 512 + h * 128;
    for (int t0 = 0; t0 < SEQ; t0 += 16) {
        { const int st = tid >> 5, c4 = (tid & 31) * 4;
#pragma unroll
          for (int a = 0; a < 3; ++a) { const unsigned long long w2 = *(const GAS unsigned long long*)(Qb + (size_t)(t0 + st) * 1536 + a * 512 + c4);
              LAS float* dst = (a == 0 ? qs : a == 1 ? ks : vs) + st * 128 + c4; const unsigned lo = (unsigned)w2, hi = (unsigned)(w2 >> 32);
              dst[0] = pg8::bf_lo(lo); dst[1] = pg8::bf_hi(lo); dst[2] = pg8::bf_lo(hi); dst[3] = pg8::bf_hi(hi); }
          if (tid < 16) { const float* gp = F.gates + (size_t)(b * SEQ + t0 + tid) * 8; fi[tid * 2] = sigmoidf_(gp[4 + h]); fi[tid * 2 + 1] = __expf(gp[h]); } }
        __syncthreads();
        for (int j = 0; j < 16; ++j) {
            const float f = fi[j * 2], ii = fi[j * 2 + 1];
            const float qa = qs[j * 128 + lane], qb = qs[j * 128 + 64 + lane], ka = ks[j * 128 + lane], kb = ks[j * 128 + 64 + lane];
            n0 = f * n0 + ii * ka; n1 = f * n1 + ii * kb;
            const float den = wave_sum(qa * n0 + qb * n1);
            const float iv = ii * vs[j * 128 + e]; float num = 0.f;
#pragma unroll
            for (int i4 = 0; i4 < 8; ++i4) { const f32x4 k4 = *(const LAS f32x4*)(ks + j * 128 + dq * 32 + i4 * 4), q4 = *(const LAS f32x4*)(qs + j * 128 + dq * 32 + i4 * 4);
                C[4 * i4 + 0] = f * C[4 * i4 + 0] + iv * k4.x; num += q4.x * C[4 * i4 + 0];
                C[4 * i4 + 1] = f * C[4 * i4 + 1] + iv * k4.y; num += q4.y * C[4 * i4 + 1];
                C[4 * i4 + 2] = f * C[4 * i4 + 2] + iv * k4.z; num += q4.z * C[4 * i4 + 2];
                C[4 * i4 + 3] = f * C[4 * i4 + 3] + iv * k4.w; num += q4.w * C[4 * i4 + 3]; }
            num += __shfl_xor(num, 16); num += __shfl_xor(num, 32);
            if (dq == 0) hs[j * 128 + e] = num / fmaxf(fabsf(den), 1.0f);
        }
        __syncthreads();
#pragma unroll
        for (int jj = 0; jj < 2; ++jj) { const int j = 2 * w + jj; const size_t row = (size_t)(b * SEQ + t0 + j);
            const float h0 = hs[j * 128 + lane], h1 = hs[j * 128 + 64 + lane]; const float ms = wave_sum(h0 * h0 + h1 * h1) * (1.0f / 128.0f); const float rs = 1.0f / sqrtf(ms + EPS);
#pragma unroll
            for (int half = 0; half < 2; ++half) { const int ee = lane + 64 * half, ci = h * 128 + ee; const float hv = half ? h1 : h0;
                const float xc = bf2f(F.XC[row * 512 + ci]), z = bf2f(F.P[row * DIN + PC_MZ + ci]);
                const float val = (hv * rs * ngp[ee] + skp[ee] * xc) * (z * sigmoidf_(z));
                F.MIX[row * 1024 + 512 + ci] = (bf16)f2bf(val); } }
        __syncthreads();
    }
}
__device__ __forceinline__ void mixers_naive_phase(Frame& F, int l) {
    LANE_SETUP
    const int bid = F.vcu;
    if (F.G < 128) return;
    if (bid < 64) { mlstm_naive(F, l, bid); return; }
    LAS float* scr = (LAS float*)(F.lds + RING_OFF + wave * 16384);
    const int nslot = (F.G - 64) * NWAVES;
    for (int it = (bid - 64) + (F.G - 64) * wave; it < 320; it += nslot) {
        if (it < 256) s5_naive(F, l, it, scr); else hgrn_naive(F, l, it - 256, scr);
    }
}

struct Args { const float* in[29]; float* out; unsigned char* ws; int ph_lo, ph_hi; };
__global__ void __launch_bounds__(NWAVES * 64, 2) fwd_kernel(Args args) {
    extern __shared__ __attribute__((aligned(16))) unsigned char lds[];
    Frame F;
    F.lds = (LAS unsigned char*)lds;
    F.MISC = (volatile LAS unsigned*)(F.lds + MISC_OFF);
    F.G = gridDim.x; { const int bx = blockIdx.x; F.vcu = (F.G % 8 == 0) ? (bx % 8) * (F.G / 8) + bx / 8 : bx; }
    unsigned char* ws = args.ws;
#define SET_WS() do { asm volatile("" : "+s"(ws)); F.ws = ws; F.par = (float*)(ws + WS_PAR); F.ss0 = (float*)(ws + WS_SS0); F.gates = (float*)(ws + WS_GATES); \
    F.XB = (bf16*)(ws + WS_XB); F.P = (bf16*)(ws + WS_P); F.MID = (bf16*)(ws + WS_MID); F.XC = (bf16*)(ws + WS_XC); F.QKV = (bf16*)(ws + WS_QKV); F.MIX = (bf16*)(ws + WS_MIX); F.YS5 = (bf16*)(ws + WS_YS5); } while (0)
    F.ctl = (gu32*)(ws + WS_CTL); F.in = args.in; F.out = args.out; SET_WS();
    for (int u = threadIdx.x; u < (LDS_BYTES - LDSCTL_OFF) / 4; u += NWAVES * 64) ((LAS unsigned*)(F.lds + LDSCTL_OFF))[u] = 0u;
    __syncthreads();
    XcdBarrier bar; bar.bar = (unsigned*)(F.ctl + CW_BAR); bar.x = 0; bar.st = nullptr;
    const bool one_launch = (args.ph_hi - args.ph_lo) > 1;
    if (one_launch) bar = xcd_barrier_post((unsigned*)(F.ctl + CW_BAR), F.MISC + 8);

    int ph_lo = args.ph_lo, ph_hi = args.ph_hi;
    if (ph_lo == 0) { p0_prologue(F); ph_lo = 1; if (ph_lo < ph_hi) xcd_barrier(bar); }
    const bool do_final = (ph_hi == NPHASE); if (do_final) ph_hi = NPHASE - 1;
    for (int ph = ph_lo; ph < ph_hi; ++ph) {
        const int l = (ph - 1) / 9, kind = 1 + (ph - 1) % 9;
        SET_WS();
        PG8_LAS unsigned char* ring = F.lds + RING_OFF;
        if (kind == 1) {
            pg8::Gemm g{F.XB, (const bf16*)(ws + WS_WIN + l * WIN_STRIDE), T, DIN, D, D}; pg8::StaticOrder S; S.init(T, DIN, F.G, (int)blockIdx.x);
            pg8::EpiScaleBf16 E{F.P, DIN, ss_arr(F, l == 0 ? 0 : 2)};
            pg8::gemm_phase<pg8::EpiScaleBf16, pg8::StaticOrder, true, true>(ring, g, S, E);
        } else if (kind == 2) prep_phase(F, l);
        else if (kind == 3) {
            for (int s = 0; s < 2; ++s) {
                pg8::Gemm g{s == 0 ? F.XC : F.P + PC_MX, s == 0 ? (const bf16*)(ws + WS_WQK + l * WQK_STRIDE) : (const bf16*)(ws + WS_WV + l * WV_STRIDE), T, s == 0 ? 1024 : 512, 512, s == 0 ? 512 : DIN};
                pg8::StaticOrder S; S.init(T, g.N, F.G, (int)blockIdx.x);
                pg8::EpiScaleBf16 E{F.QKV + (s == 0 ? 0 : 1024), 1536, nullptr};
                pg8::gemm_phase<pg8::EpiScaleBf16, pg8::StaticOrder, true, true>(ring, g, S, E);
            }
        } else if (kind == 4) gates_phase(F, l);
        else if (kind == 5) mixers_naive_phase(F, l);
        else if (kind == 6) {
            pg8::Gemm g{F.YS5, (const bf16*)(ws + WS_WGLU + l * WGLU_STRIDE), T, 256, 256, 256}; pg8::StaticOrder S; S.init(T, 256, F.G, (int)blockIdx.x);
            pg8::EpiGlu E{F.YS5, F.MIX, 1024, 256};
            pg8::gemm_phase<pg8::EpiGlu, pg8::StaticOrder, true, true>(ring, g, S, E);
        } else if (kind == 7 || kind == 9) {
            pg8::Gemm g{kind == 7 ? F.MIX : F.MID, kind == 7 ? (const bf16*)(ws + WS_WOUT + l * WOUT_STRIDE) : (const bf16*)(ws + WS_WD + l * WD_STRIDE), T, D, kind == 7 ? D : DFF, kind == 7 ? D : DFF};
            pg8::StaticOrder S; S.init(T, D, F.G, (int)blockIdx.x);
            pg8::EpiResid E{(kind == 7 && l == 0) ? F.in[0] : F.out, F.out, F.XB, ss_arr(F, 2 * l + (kind == 7 ? 1 : 2))};
            pg8::gemm_phase<pg8::EpiResid, pg8::StaticOrder, true, true>(ring, g, S, E);
        } else if (kind == 8) {
            pg8::Gemm g{F.XB, (const bf16*)(ws + WS_WGU + l * WGU_STRIDE), T, 2 * DFF, D, D}; pg8::StaticOrder S; S.init(T, 2 * DFF, F.G, (int)blockIdx.x);
            pg8::EpiSwiglu E{F.MID, DFF, ss_arr(F, 2 * l + 1)};
            pg8::gemm_phase<pg8::EpiSwiglu, pg8::StaticOrder, true, true>(ring, g, S, E);
        }
        if (ph + 1 < ph_hi || do_final) xcd_barrier(bar);
    }
    if (do_final) { SET_WS(); final_phase(F); }
}

extern "C" void kernel_launch(void* const* d_in, const int* in_sizes, int n_in, void* d_out, int out_size, void* d_ws, size_t ws_size, hipStream_t stream) {
    static int grid = 0;
    if (grid == 0) {
        if (n_in != 29 || in_sizes[0] != T * D || out_size != T * D || ws_size < WS_END) { fprintf(stderr, "kernel_launch: unexpected shapes (n_in %d in0 %d out %d ws %zu)\n", n_in, n_in > 0 ? in_sizes[0] : -1, out_size, ws_size); grid = -1; return; }
        int dev = 0, cus = 0, per_cu = 0;
        if (hipGetDevice(&dev) != hipSuccess || hipDeviceGetAttribute(&cus, hipDeviceAttributeMultiprocessorCount, dev) != hipSuccess) { grid = -1; return; }
        if (hipFuncSetAttribute((const void*)fwd_kernel, hipFuncAttributeMaxDynamicSharedMemorySize, LDS_BYTES) != hipSuccess) { fprintf(stderr, "kernel_launch: hipFuncSetAttribute failed\n"); grid = -1; return; }
        if (hipOccupancyMaxActiveBlocksPerMultiprocessor(&per_cu, (const void*)fwd_kernel, NWAVES * 64, LDS_BYTES) != hipSuccess || per_cu < 1) fprintf(stderr, "kernel_launch: occupancy query reports %d\n", per_cu);
        (void)hipGetLastError();
        grid = cus;
    }
    if (grid < 0) return;
    if (hipMemsetAsync((char*)d_ws + WS_CTL, 0, CTL_ZERO_BYTES, stream) != hipSuccess) return;
    Args a{};
    for (int i = 0; i < 29; ++i) a.in[i] = (const float*)d_in[i];
    a.out = (float*)d_out; a.ws = (unsigned char*)d_ws;
#if MK_ONE_LAUNCH
    a.ph_lo = 0; a.ph_hi = NPHASE;
    hipLaunchKernelGGL(fwd_kernel, dim3(grid), dim3(NWAVES * 64), LDS_BYTES, stream, a);
#else
    for (int ph = 0; ph < NPHASE; ++ph) { a.ph_lo = ph; a.ph_hi = ph + 1; hipLaunchKernelGGL(fwd_kernel, dim3(grid), dim3(NWAVES * 64), LDS_BYTES, stream, a); }
#endif
}
```

```cpp
#include <hip/hip_runtime.h>
#include <cstdio>
#include <cstdint>
#define GAS __attribute__((address_space(1)))
namespace pg8 {
#define PG8_LAS __attribute__((address_space(3)))
typedef unsigned short bf16_t;
typedef short bf16x8 __attribute__((ext_vector_type(8)));
typedef float f32x4 __attribute__((ext_vector_type(4)));
typedef unsigned u32x4 __attribute__((ext_vector_type(4)));
constexpr int BM = 256, BK = 64, HALF = 128, HTB = HALF * BK * 2  , STAGE_BYTES = 8 * HTB, NXCD = 8, WGM = 8;

__host__ __device__ __forceinline__ int lds_byte(int r, int c) { const int st = (r >> 4) * 2 + (c >> 5), rr = r & 15, cc = c & 31, ob = rr * 64 + cc * 2; return st * 1024 + (ob ^ (((ob >> 9) & 1) << 5)); }
__host__ __device__ __forceinline__ void stage_rc(int b, int& R, int& C) { const int st = b / 1024, sb = b % 1024, swz = sb ^ (((sb >> 9) & 1) << 5); R = (st >> 1) * 16 + swz / 64; C = (st & 1) * 32 + (swz % 64) / 2; }
__host__ __device__ __forceinline__ int perm32(int rho) { const int n = rho >> 4, i = rho & 15; return 8 * (i >> 2) + 4 * n + (i & 3); }

struct Unit { int pm, pn; };
struct Gemm { const bf16_t* A; const bf16_t* Bt; int M, N, K, lda, amask, astep; };

struct StaticOrder {
    int nM, nN, nwg, G, c, rev;
    __host__ __device__ void init(int M, int N, int G_, int c_) { nM = M / BM; nN = N / BM; nwg = nM * nN; G = G_; c = c_; rev = 0; ss = nullptr; rsl = nullptr; }
    __host__ __device__ bool next(int i, Unit& u) const {
        const long L = (long)i * G + c; if (L >= nwg) return false;
        int wgid = rev ? nwg - 1 - (int)L : (int)L;
        const int nig = WGM * nN, gid = wgid / nig, fm = gid * WGM, gsz = (nM - fm) < WGM ? (nM - fm) : WGM;
        u.pm = fm + ((wgid % nig) % gsz); u.pn = (wgid % nig) / gsz; return true;
    }
    const GAS float* ss; PG8_LAS float* rsl;
    __device__ __forceinline__ void a_ready(const Unit& u, int ui) const {
        if (ss) { int t_ = threadIdx.x; asm volatile("" : "+v"(t_));
            if (t_ < 256) { const GAS float* p = ss + (size_t)(u.pm * BM + t_) * 16;
                const f32x4 a = *(const GAS f32x4*)p, b = *(const GAS f32x4*)(p + 4), c = *(const GAS f32x4*)(p + 8), d = *(const GAS f32x4*)(p + 12);
                const float s = (((a[0] + a[1]) + (a[2] + a[3])) + ((b[0] + b[1]) + (b[2] + b[3]))) + (((c[0] + c[1]) + (c[2] + c[3])) + ((d[0] + d[1]) + (d[2] + d[3])));
                rsl[(ui & 1) * 256 + t_] = __builtin_amdgcn_rsqf(s * (1.0f / 1024.0f) + 1e-6f); } }
    }
    __device__ __forceinline__ void done(const Unit&) const {}
};

typedef float f32x2 __attribute__((ext_vector_type(2)));
typedef __bf16 bf16x2v __attribute__((ext_vector_type(2)));
__device__ __forceinline__ unsigned cvt_pk_bf16(float lo, float hi) { f32x2 v = {lo, hi}; bf16x2v b = __builtin_convertvector(v, bf16x2v); return __builtin_bit_cast(unsigned, b); }
__device__ __forceinline__ float bf_lo(unsigned w) { return __builtin_bit_cast(float, w << 16); }
__device__ __forceinline__ float bf_hi(unsigned w) { return __builtin_bit_cast(float, w & 0xffff0000u); }
__device__ __forceinline__ float fast_sigmoid(float x) { return __builtin_amdgcn_rcpf(1.0f + __expf(-x)); }
constexpr float RMS_EPS = 1e-6f;
__device__ __forceinline__ float row_rs4(const GAS float* ss16, int row, int fq) {
    const f32x4 a = *(const GAS f32x4*)(ss16 + (size_t)row * 16 + 4 * fq);
    float s = (a[0] + a[1]) + (a[2] + a[3]);
    s += __shfl_xor(s, 16); s += __shfl_xor(s, 32);
    return __builtin_amdgcn_rsqf(s * (1.0f / 1024.0f) + RMS_EPS);
}
__device__ __forceinline__ float row_rs(const GAS float* ss16, int row) {
    const f32x4 a = *(const GAS f32x4*)(ss16 + (size_t)row * 16), b = *(const GAS f32x4*)(ss16 + (size_t)row * 16 + 4), c = *(const GAS f32x4*)(ss16 + (size_t)row * 16 + 8), d = *(const GAS f32x4*)(ss16 + (size_t)row * 16 + 12);
    const float s = (((a[0] + a[1]) + (a[2] + a[3])) + ((b[0] + b[1]) + (b[2] + b[3]))) + (((c[0] + c[1]) + (c[2] + c[3])) + ((d[0] + d[1]) + (d[2] + d[3])));
    return __builtin_amdgcn_rsqf(s * (1.0f / 1024.0f) + RMS_EPS);
}
#define EPI_LANES int t_ = threadIdx.x; asm volatile("" : "+v"(t_)); const int wid_ = __builtin_amdgcn_readfirstlane(t_ >> 6), wr = wid_ >> 2, wc = wid_ & 3, fr = t_ & 15, fq = (t_ & 63) >> 4, elane = t_ & 63; (void)elane;
struct EpiScaleBf16 {
    static constexpr bool PERM = true, AFTER_DRAIN = false;
    GAS bf16_t* O; int ldc; const PG8_LAS float* rsl;
    __device__ __forceinline__ void operator()(const f32x4 (&acc)[2][2][4][2], const Unit& u, int ui, int, int, int) const {
        EPI_LANES
        const int row0 = u.pm * BM + wr * 64 + fr, col0 = u.pn * BM + wc * 32 + 8 * fq;
#pragma unroll
        for (int ai = 0; ai < 2; ++ai)
#pragma unroll
            for (int m = 0; m < 4; ++m) { const int row = row0 + ai * HALF + m * 16; const float rs = rsl ? rsl[(ui & 1) * 256 + wr * 64 + ai * HALF + m * 16 + fr] : 1.0f;
                GAS bf16_t* rowp = O + (size_t)row * ldc + col0;
#pragma unroll
                for (int bj = 0; bj < 2; ++bj) { const f32x4 v0 = acc[ai][bj][m][0] * rs, v1 = acc[ai][bj][m][1] * rs;
                    u32x4 w; w.x = cvt_pk_bf16(v0[0], v0[1]); w.y = cvt_pk_bf16(v0[2], v0[3]); w.z = cvt_pk_bf16(v1[0], v1[1]); w.w = cvt_pk_bf16(v1[2], v1[3]);
                    *(GAS u32x4*)(rowp + bj * HALF) = w; } }
    }
};
struct EpiGlu {
    static constexpr bool PERM = true, AFTER_DRAIN = false;
    const GAS bf16_t* Y; GAS bf16_t* O; int ldc, ocol;
    __device__ __forceinline__ void operator()(const f32x4 (&acc)[2][2][4][2], const Unit& u, int ui, int, int, int) const {
        EPI_LANES
        const int row0 = u.pm * BM + wr * 64 + fr, col0 = u.pn * BM + wc * 32 + 8 * fq;
#pragma unroll
        for (int ai = 0; ai < 2; ++ai)
#pragma unroll
            for (int m = 0; m < 4; ++m) { const int row = row0 + ai * HALF + m * 16;
#pragma unroll
                for (int bj = 0; bj < 2; ++bj) { const u32x4 yv = *(const GAS u32x4*)(Y + (size_t)row * 256 + col0 + bj * HALF);
                    const f32x4 a0 = acc[ai][bj][m][0], a1 = acc[ai][bj][m][1];
                    u32x4 w;
                    w.x = cvt_pk_bf16(bf_lo(yv.x) * fast_sigmoid(a0[0]), bf_hi(yv.x) * fast_sigmoid(a0[1]));
                    w.y = cvt_pk_bf16(bf_lo(yv.y) * fast_sigmoid(a0[2]), bf_hi(yv.y) * fast_sigmoid(a0[3]));
                    w.z = cvt_pk_bf16(bf_lo(yv.z) * fast_sigmoid(a1[0]), bf_hi(yv.z) * fast_sigmoid(a1[1]));
                    w.w = cvt_pk_bf16(bf_lo(yv.w) * fast_sigmoid(a1[2]), bf_hi(yv.w) * fast_sigmoid(a1[3]));
                    *(GAS u32x4*)(O + (size_t)row * ldc + ocol + col0 + bj * HALF) = w; }
                asm volatile("" ::: "memory"); }
    }
};
struct EpiResid {
    static constexpr bool PERM = true, AFTER_DRAIN = false;
    const GAS float* x32; GAS bf16_t* xb; GAS float* ss;
    __device__ __forceinline__ void operator()(const f32x4 (&acc)[2][2][4][2], const Unit& u, int ui, int, int, int) const {
        EPI_LANES
        const int row0 = u.pm * BM + wr * 64 + fr, col0 = u.pn * BM + wc * 32 + 8 * fq;
#pragma unroll
        for (int ai = 0; ai < 2; ++ai)
#pragma unroll
            for (int m = 0; m < 4; ++m) { const int row = row0 + ai * HALF + m * 16; const size_t off = (size_t)row * 1024 + col0; float s = 0.f;
#pragma unroll
                for (int bj = 0; bj < 2; ++bj) { f32x4 r0, r1;
                    if (x32) { r0 = *(const GAS f32x4*)(x32 + off + bj * HALF); r1 = *(const GAS f32x4*)(x32 + off + bj * HALF + 4); }
                    else { const u32x4 rb = *(const GAS u32x4*)(xb + off + bj * HALF); r0 = (f32x4){bf_lo(rb.x), bf_hi(rb.x), bf_lo(rb.y), bf_hi(rb.y)}; r1 = (f32x4){bf_lo(rb.z), bf_hi(rb.z), bf_lo(rb.w), bf_hi(rb.w)}; }
                    const f32x4 v0 = r0 + acc[ai][bj][m][0], v1 = r1 + acc[ai][bj][m][1];
                    s += ((v0[0] * v0[0] + v0[1] * v0[1]) + (v0[2] * v0[2] + v0[3] * v0[3])) + ((v1[0] * v1[0] + v1[1] * v1[1]) + (v1[2] * v1[2] + v1[3] * v1[3]));
                    u32x4 w; w.x = cvt_pk_bf16(v0[0], v0[1]); w.y = cvt_pk_bf16(v0[2], v0[3]); w.z = cvt_pk_bf16(v1[0], v1[1]); w.w = cvt_pk_bf16(v1[2], v1[3]);
                    *(GAS u32x4*)(xb + off + bj * HALF) = w; }
                s += __builtin_bit_cast(float, __builtin_amdgcn_ds_bpermute((elane ^ 16) << 2, __builtin_bit_cast(int, s))); s += __builtin_bit_cast(float, __builtin_amdgcn_ds_bpermute((elane ^ 32) << 2, __builtin_bit_cast(int, s)));
                if (fq == 0) ss[(size_t)row * 16 + u.pn * 4 + wc] = s; }
    }
};
struct EpiSwiglu {
    static constexpr bool PERM = true, AFTER_DRAIN = false;
    GAS bf16_t* O; int ldc; const PG8_LAS float* rsl;
    __device__ __forceinline__ void operator()(const f32x4 (&acc)[2][2][4][2], const Unit& u, int ui, int, int, int) const {
        EPI_LANES
        const int row0 = u.pm * BM + wr * 64 + fr, col0 = u.pn * HALF + wc * 32 + 8 * fq;
#pragma unroll
        for (int ai = 0; ai < 2; ++ai)
#pragma unroll
            for (int m = 0; m < 4; ++m) { const int row = row0 + ai * HALF + m * 16; const float rs = rsl[(ui & 1) * 256 + wr * 64 + ai * HALF + m * 16 + fr], nrsl = rs * -1.4426950408889634f, rs2 = rs * rs; (void)row0;
                float o[8];
#pragma unroll
                for (int n = 0; n < 2; ++n)
#pragma unroll
                    for (int j = 0; j < 4; ++j) { const float g = acc[ai][0][m][n][j], up = acc[ai][1][m][n][j];
                        const float r = __builtin_amdgcn_rcpf(1.0f + __builtin_amdgcn_exp2f(g * nrsl)); o[n * 4 + j] = (g * up) * (r * rs2); }
                u32x4 w; w.x = cvt_pk_bf16(o[0], o[1]); w.y = cvt_pk_bf16(o[2], o[3]); w.z = cvt_pk_bf16(o[4], o[5]); w.w = cvt_pk_bf16(o[6], o[7]);
                *(GAS u32x4*)(O + (size_t)row * ldc + col0) = w; }
    }
};

template <class Epi, class Sched, bool ALIGN_EPI = false, bool SP2 = false>
__device__ __forceinline__ void gemm_phase(PG8_LAS unsigned char* lds, const Gemm g, const Sched& S, const Epi& E) {
    int tid_ = threadIdx.x; asm volatile("" : "+v"(tid_));
    const int tid = tid_, wid = __builtin_amdgcn_readfirstlane(tid >> 6), lane = tid & 63, wr = wid >> 2, wc = wid & 3, fr = lane & 15, fq = lane >> 4;
    const int K = g.K, nt = K / BK, lda = g.lda;
    unsigned voffA[2], voffB[2];
#pragma unroll
    for (int i = 0; i < 2; ++i) { int R, C; stage_rc(tid * 16 + i * 8192, R, C); const int Rb = Epi::PERM ? ((R & ~31) + perm32(R & 31)) : R;
        voffA[i] = (unsigned)(R * lda + C) * 2u; voffB[i] = (unsigned)(Rb * K + C) * 2u; }
    const size_t kstep = (size_t)(BK * 2);
    const size_t hstep = (size_t)HALF * K * 2;
    const size_t tstep = 2 * hstep; const size_t hstepA = (size_t)HALF * lda * 2, tstepA = 2 * hstepA;
    const unsigned ldsw = (unsigned)wid * 1024u;
    const int aoff = lds_byte(wr * 64 + fr, fq * 8), boff = lds_byte(wc * 32 + fr, fq * 8);
#define PG8_SA(b, h) (((b) * 2 + (h)) * HTB)
#define PG8_SB(b, h) ((4 + (b) * 2 + (h)) * HTB)
#define PG8_STAGE(bufoff, gbase, voff) do { _Pragma("unroll") for (int _i = 0; _i < 2; ++_i) \
        __builtin_amdgcn_global_load_lds((const unsigned*)((const char*)(gbase) + (voff)[_i]), (PG8_LAS unsigned*)(lds + (bufoff) + ldsw + _i * 8192), 16, 0, 0); } while (0)
#define PG8_LDA(dst, b, h) do { _Pragma("unroll") for (int m = 0; m < 4; ++m) _Pragma("unroll") for (int k = 0; k < 2; ++k) dst[m][k] = *(const PG8_LAS bf16x8*)(lds + PG8_SA(b, h) + aoff + m * 2048 + k * 1024); } while (0)
#define PG8_LDB(dst, b, h) do { _Pragma("unroll") for (int n = 0; n < 2; ++n) _Pragma("unroll") for (int k = 0; k < 2; ++k) dst[n][k] = *(const PG8_LAS bf16x8*)(lds + PG8_SB(b, h) + boff + n * 2048 + k * 1024); } while (0)
#define PG8_MMA(ai, bj, At, Bt) do { __builtin_amdgcn_s_setprio(1); _Pragma("unroll") for (int m = 0; m < 4; ++m) _Pragma("unroll") for (int n = 0; n < 2; ++n) _Pragma("unroll") for (int k = 0; k < 2; ++k) \
        acc[ai][bj][m][n] = __builtin_amdgcn_mfma_f32_16x16x32_bf16(Bt[n][k], At[m][k], acc[ai][bj][m][n], 0, 0, 0); __builtin_amdgcn_s_setprio(0); } while (0)
#define PG8_WAIT_V(n) asm volatile("s_waitcnt vmcnt(" #n ")" ::: "memory")
#define PG8_WAIT_L(n) asm volatile("s_waitcnt lgkmcnt(" #n ")" ::: "memory")
#define PG8_BAR __builtin_amdgcn_s_barrier()
#define PG8_SCHED __builtin_amdgcn_sched_barrier(0)
    Unit cur, nxt; int ui = 0;
    if (!S.next(0, cur)) return;
    f32x4 acc[2][2][4][2];
#pragma unroll
    for (int a = 0; a < 2; ++a)
#pragma unroll
        for (int b = 0; b < 2; ++b)
#pragma unroll
            for (int m = 0; m < 4; ++m)
#pragma unroll
                for (int n = 0; n < 2; ++n) acc[a][b][m][n] = (f32x4){0.f, 0.f, 0.f, 0.f};
    bf16x8 At[4][2], B0[2][2], B1[2][2];
    const char* cA = (const char*)g.A + (size_t)cur.pm * tstepA + (size_t)((cur.pn & g.amask) * g.astep) * 2; const char* cB = (const char*)g.Bt + (size_t)cur.pn * tstep;
    S.a_ready(cur, 0);
    if constexpr (SP2) {
        PG8_STAGE(PG8_SB(0, 0), cB, voffB); PG8_STAGE(PG8_SB(0, 1), cB + hstep, voffB); PG8_STAGE(PG8_SA(0, 0), cA, voffA); PG8_STAGE(PG8_SA(0, 1), cA + hstepA, voffA);
        if (wr == 1) PG8_BAR;
        PG8_WAIT_V(2); PG8_BAR;
        PG8_STAGE(PG8_SB(1, 0), cB + kstep, voffB); PG8_STAGE(PG8_SA(1, 0), cA + kstep, voffA); PG8_STAGE(PG8_SB(1, 1), cB + hstep + kstep, voffB);
        PG8_WAIT_V(6); PG8_BAR;
    } else {
        PG8_STAGE(PG8_SB(0, 0), cB, voffB); PG8_STAGE(PG8_SA(0, 0), cA, voffA); PG8_STAGE(PG8_SB(0, 1), cB + hstep, voffB); PG8_STAGE(PG8_SA(0, 1), cA + hstepA, voffA);
        if (wr == 1) PG8_BAR;
        PG8_WAIT_V(4); PG8_BAR;
        PG8_STAGE(PG8_SB(1, 0), cB + kstep, voffB); PG8_STAGE(PG8_SA(1, 0), cA + kstep, voffA); PG8_STAGE(PG8_SB(1, 1), cB + hstep + kstep, voffB);
        PG8_WAIT_V(6); PG8_BAR;
    }
    for (;;) {
        const bool has_next = S.next(ui + 1, nxt);
        const char* nA = has_next ? (const char*)g.A + (size_t)nxt.pm * tstepA + (size_t)((nxt.pn & g.amask) * g.astep) * 2 : cA; const char* nB = has_next ? (const char*)g.Bt + (size_t)nxt.pn * tstep : cB;
        for (int t = 0; t < nt; t += 2) {
            const bool last = (t == nt - 2);
            const char* a1 = cA + (size_t)(t + 1) * kstep;
            const char* a2 = last ? nA : cA + (size_t)(t + 2) * kstep; const char* b2 = last ? nB : cB + (size_t)(t + 2) * kstep;
            const char* a3 = a2 + kstep; const char* b3 = b2 + kstep;
            if (last && has_next) S.a_ready(nxt, ui + 1);
            if constexpr (SP2) {
            PG8_LDB(B0, 0, 0); PG8_LDB(B1, 0, 1); PG8_SCHED; PG8_LDA(At, 0, 0); PG8_STAGE(PG8_SA(1, 1), a1 + hstepA, voffA);
            PG8_WAIT_V(8); PG8_WAIT_L(0); PG8_BAR; PG8_MMA(0, 0, At, B0); PG8_MMA(0, 1, At, B1); PG8_BAR; PG8_SCHED;
            PG8_LDA(At, 0, 1); PG8_STAGE(PG8_SB(0, 0), b2, voffB); PG8_STAGE(PG8_SB(0, 1), b2 + hstep, voffB); PG8_STAGE(PG8_SA(0, 0), a2, voffA);
            PG8_WAIT_V(8); PG8_WAIT_L(0); PG8_BAR; PG8_MMA(1, 0, At, B0); PG8_MMA(1, 1, At, B1); PG8_BAR; PG8_SCHED;
            PG8_LDB(B0, 1, 0); PG8_LDB(B1, 1, 1); PG8_SCHED; PG8_LDA(At, 1, 0); PG8_STAGE(PG8_SA(0, 1), a2 + hstepA, voffA);
            PG8_WAIT_V(8); PG8_WAIT_L(0); PG8_BAR; PG8_MMA(0, 0, At, B0); PG8_MMA(0, 1, At, B1); PG8_BAR; PG8_SCHED;
            PG8_LDA(At, 1, 1); PG8_STAGE(PG8_SB(1, 0), b3, voffB); PG8_STAGE(PG8_SB(1, 1), b3 + hstep, voffB); PG8_STAGE(PG8_SA(1, 0), a3, voffA);
            PG8_WAIT_V(8); PG8_WAIT_L(0); PG8_BAR; PG8_MMA(1, 0, At, B0); PG8_MMA(1, 1, At, B1); PG8_BAR; PG8_SCHED;
            } else {
            PG8_LDB(B0, 0, 0); PG8_SCHED; PG8_LDA(At, 0, 0); PG8_STAGE(PG8_SA(1, 1), a1 + hstepA, voffA);
            PG8_WAIT_L(8); PG8_BAR; PG8_WAIT_L(0); PG8_MMA(0, 0, At, B0); PG8_BAR; PG8_SCHED;
            PG8_LDB(B1, 0, 1); PG8_STAGE(PG8_SB(0, 0), b2, voffB);
            PG8_BAR; PG8_WAIT_L(0); PG8_MMA(0, 1, At, B1); PG8_BAR;
            PG8_LDA(At, 0, 1); PG8_STAGE(PG8_SA(0, 0), a2, voffA);
            PG8_BAR; PG8_WAIT_L(0); PG8_MMA(1, 0, At, B0); PG8_BAR; PG8_SCHED;
            PG8_STAGE(PG8_SB(0, 1), b2 + hstep, voffB);
            PG8_WAIT_V(6); PG8_BAR; PG8_MMA(1, 1, At, B1); PG8_BAR;
            PG8_LDB(B0, 1, 0); PG8_SCHED; PG8_LDA(At, 1, 0); PG8_STAGE(PG8_SA(0, 1), a2 + hstepA, voffA);
            PG8_WAIT_L(8); PG8_BAR; PG8_WAIT_L(0); PG8_MMA(0, 0, At, B0); PG8_BAR; PG8_SCHED;
            PG8_LDB(B1, 1, 1); PG8_STAGE(PG8_SB(1, 0), b3, voffB);
            PG8_BAR; PG8_WAIT_L(0); PG8_MMA(0, 1, At, B1); PG8_BAR;
            PG8_LDA(At, 1, 1); PG8_STAGE(PG8_SA(1, 0), a3, voffA);
            PG8_BAR; PG8_WAIT_L(0); PG8_MMA(1, 0, At, B0); PG8_BAR; PG8_SCHED;
            PG8_STAGE(PG8_SB(1, 1), b3 + hstep, voffB);
            PG8_WAIT_V(6); PG8_BAR; PG8_MMA(1, 1, At, B1); PG8_BAR;
            }
        }
        if constexpr (ALIGN_EPI) { if (wr == 0) PG8_BAR; }
        if constexpr (!Epi::AFTER_DRAIN) { E(acc, cur, ui, wc, fr, fq); S.done(cur); }
        if (!has_next) break;
#pragma unroll
        for (int a = 0; a < 2; ++a)
#pragma unroll
            for (int b = 0; b < 2; ++b)
#pragma unroll
                for (int m = 0; m < 4; ++m)
#pragma unroll
                    for (int n = 0; n < 2; ++n) acc[a][b][m][n] = (f32x4){0.f, 0.f, 0.f, 0.f};
        cur = nxt; cA = nA; cB = nB; ++ui;
        if constexpr (ALIGN_EPI) { if (wr == 1) PG8_BAR; }
    }
    PG8_WAIT_V(0);
    if constexpr (!ALIGN_EPI) { if (wr == 0) PG8_BAR; }
    PG8_BAR;
    if constexpr (Epi::AFTER_DRAIN) { E.fused(acc, cur, wr, wc, fr, fq, lds, wid, lane); S.done(cur); }
#undef PG8_SA
#undef PG8_SB
#undef PG8_STAGE
#undef PG8_LDA
#undef PG8_LDB
#undef PG8_MMA
#undef PG8_WAIT_V
#undef PG8_WAIT_L
#undef PG8_BAR
#undef PG8_SCHED
}
}
constexpr int NB = 16, SEQ = 2048, D = 1024, T = NB * SEQ, DIN = 2304, DFF = 2816, DEPTH = 2;
constexpr int NWAVES = 8;
constexpr int PC_Q = 0, PC_F = 256, PC_I = 512, PC_G = 768, PC_U = 1024, PC_MX = 1280, PC_MZ = 1792;
constexpr float EPS = 1e-6f;
constexpr int NPHASE = 18, KPL = 8;
#ifndef MK_ONE_LAUNCH
#define MK_ONE_LAUNCH 1
#endif

constexpr size_t MiB = 1u << 20;
constexpr size_t WS_CTL = 0, CTL_ZERO_BYTES = 1 * MiB;
constexpr size_t WS_PAR = 1 * MiB;
constexpr size_t WS_SS0 = 2 * MiB;
constexpr size_t WS_GATES = 3 * MiB;
constexpr size_t WS_WIN = 4 * MiB, WIN_STRIDE = 6 * MiB;
constexpr size_t WS_WOUT = 16 * MiB, WOUT_STRIDE = 2 * MiB;
constexpr size_t WS_WGU = 20 * MiB, WGU_STRIDE = 11 * MiB;
constexpr size_t WS_WD = 42 * MiB, WD_STRIDE = 6 * MiB;
constexpr size_t WS_WQK = 54 * MiB, WQK_STRIDE = 1 * MiB;
constexpr size_t WS_WV = 56 * MiB, WV_STRIDE = MiB / 2;
constexpr size_t WS_WGLU = 57 * MiB, WGLU_STRIDE = MiB / 8;
constexpr size_t WS_HDEC = 58 * MiB;
constexpr size_t WS_XB = 64 * MiB;
constexpr size_t WS_P = 128 * MiB;
constexpr size_t WS_MID = 128 * MiB;
constexpr size_t WS_XC = 272 * MiB;
constexpr size_t WS_QKV = 304 * MiB;
constexpr size_t WS_MIX = 400 * MiB;
constexpr size_t WS_YS5 = 464 * MiB;
constexpr size_t WS_SS = 480 * MiB;
constexpr size_t WS_END = 490 * MiB;
static_assert(WS_MID + (size_t)T * DFF * 2 <= WS_QKV && WS_P + (size_t)T * DIN * 2 <= WS_XC, "d_ws map");
constexpr int CW_TMO = 0, CW_CODE = 1, CW_WCTR = 64, CW_BAR = 4096;
constexpr size_t CTL_SS_OFF = 256 * 1024;
constexpr int PAR_LBV = 0, PAR_S5A = 1024, PAR_S5BB = 8192, PAR_G1 = 73728, PAR_G2 = 81920;

constexpr int RING_OFF = 0, RING_BYTES = 131072;
constexpr int LDSCTL_OFF = RING_BYTES, MISC_OFF = LDSCTL_OFF + 320;
constexpr int LDS_BYTES = 147456;

#define LAS __attribute__((address_space(3)))
typedef unsigned short bf16;
typedef unsigned v4u __attribute__((ext_vector_type(4)));
typedef float f32x4 __attribute__((ext_vector_type(4)));
typedef short bf16x8 __attribute__((ext_vector_type(8)));
typedef GAS unsigned gu32;
typedef GAS unsigned long long gu64;
#define RLX_AGENT __ATOMIC_RELAXED, __HIP_MEMORY_SCOPE_AGENT
#define LDS_WAIT() asm volatile("s_waitcnt lgkmcnt(0)" ::: "memory")
#define VM_WAIT() asm volatile("s_waitcnt vmcnt(0)" ::: "memory")
__device__ __forceinline__ unsigned long long rt() { return __builtin_amdgcn_s_memrealtime(); }
__device__ __forceinline__ unsigned f2bf(float f) { unsigned u = __builtin_bit_cast(unsigned, f); return (u + 0x7fffu + ((u >> 16) & 1u)) >> 16; }
__device__ __forceinline__ unsigned pk2(float lo, float hi) { return f2bf(lo) | (f2bf(hi) << 16); }
#define XB_TMO      128
#define XB_XCNT(j)  (256  + 64 * (j))
#define XB_XSUB(j)  (1280 + 64 * (j))
#define XB_XGEN(j)  (2304 + 64 * (j))
#define XB_TOP      3328
#define XB_TOPGEN   3392
#define XCD_BAR_WORDS 3456
#define XB_SPIN_CAP (1u << 18)

__device__ __forceinline__ unsigned xb_ld(unsigned* p)              { return __hip_atomic_load(p, __ATOMIC_RELAXED, __HIP_MEMORY_SCOPE_AGENT); }
__device__ __forceinline__ unsigned xb_add(unsigned* p, unsigned v) { return __hip_atomic_fetch_add(p, v, __ATOMIC_RELAXED, __HIP_MEMORY_SCOPE_AGENT); }
__device__ __forceinline__ unsigned xb_xcc_id() { return (unsigned)__builtin_amdgcn_s_getreg((3 << 11) | 20) & 0xFu; }
#define XB_SPIN(cond, bar) do { unsigned _sp = 0; while (cond) { __builtin_amdgcn_s_sleep(1); \
    if ((++_sp & 255u) == 0u) { if (xb_ld(&(bar)[XB_TMO])) break; if (_sp > XB_SPIN_CAP) { atomicAdd(&(bar)[XB_TMO], 1u); break; } } } } while (0)

struct XcdBarrier {
    unsigned* bar; unsigned x;
    unsigned gexp;
    volatile LAS unsigned* st;
};

__device__ __forceinline__ XcdBarrier xcd_barrier_post(unsigned* bar, volatile LAS unsigned* st) {
    XcdBarrier b; b.bar = bar; b.x = xb_xcc_id(); b.st = st; b.gexp = 0u;
    if (threadIdx.x == 0) (void)xb_add(&bar[XB_XCNT(b.x)], 1u);
    return b;
}
__device__ __forceinline__ void xcd_barrier_complete(unsigned* bar, unsigned x, unsigned& nloc, unsigned& nx, unsigned gexp) {
    const unsigned G = gexp ? gexp : gridDim.x * gridDim.y * gridDim.z;
    unsigned sum, cnt, mine, sp = 0u;
    for (;;) {
        sum = 0u; cnt = 0u; mine = 0u;
#pragma unroll
        for (unsigned j = 0; j < 16; ++j) { const unsigned c = xb_ld(&bar[XB_XCNT(j)]); sum += c; cnt += (c > 0u) ? 1u : 0u; mine = (j == x) ? c : mine; }
        if (sum == G) break;
        __builtin_amdgcn_s_sleep(1);
        if ((++sp & 255u) == 0u) { if (xb_ld(&bar[XB_TMO])) break; if (sp > XB_SPIN_CAP) { atomicAdd(&bar[XB_TMO], 1u); break; } }
    }
    nloc = mine > 0u ? mine : 1u; nx = cnt > 0u ? cnt : 1u;
}

__device__ __forceinline__ void xcd_barrier(const XcdBarrier& b) {
    asm volatile("s_waitcnt vmcnt(0)" ::: "memory");
    __syncthreads();
    if (threadIdx.x == 0) {
        unsigned* bar = b.bar;
        __builtin_amdgcn_s_waitcnt(0);
        unsigned nloc = b.st[0], nx = b.st[1];
        if (nloc == 0u) { xcd_barrier_complete(bar, b.x, nloc, nx, b.gexp); b.st[0] = nloc; b.st[1] = nx; }
        const unsigned old = xb_add(&bar[XB_XSUB(b.x)], 1u);
        const unsigned gen = old / nloc;
        if (old + 1u == (gen + 1u) * nloc) {
            __builtin_amdgcn_fence(__ATOMIC_RELEASE, "agent");
            asm volatile("s_waitcnt vmcnt(0)" ::: "memory");
            const unsigned og = xb_add(&bar[XB_TOP], 1u);
            const unsigned tg = og / nx;
            if (og + 1u == (tg + 1u) * nx) xb_add(&bar[XB_TOPGEN], 1u);
            else XB_SPIN(xb_ld(&bar[XB_TOPGEN]) == tg, bar);
            __builtin_amdgcn_fence(__ATOMIC_ACQUIRE, "agent");
            xb_add(&bar[XB_XGEN(b.x)], 1u);
            asm volatile("s_waitcnt vmcnt(0)" ::: "memory");
        } else {
            XB_SPIN(xb_ld(&bar[XB_XGEN(b.x)]) == gen, bar);
            __builtin_amdgcn_fence(__ATOMIC_ACQUIRE, "agent");
            asm volatile("s_waitcnt vmcnt(0)" ::: "memory");
        }
    }
    __syncthreads();
}
typedef unsigned u32x2 __attribute__((ext_vector_type(2)));
struct Frame {
    LAS unsigned char* lds;
    volatile LAS unsigned* MISC;
    gu32* ctl;
    int vcu, G;
    const float* const* in;
    GAS float* out;
    GAS unsigned char* ws;
    GAS float* par; GAS float* ss0; GAS float* gates;
    GAS bf16 *XB, *P, *MID, *XC, *QKV, *MIX, *YS5;
};
__device__ __forceinline__ GAS float* ss_arr(Frame& F, int i) { return (GAS float*)(F.ws + WS_SS) + (size_t)i * T * 16; }
__device__ __forceinline__ float bf2f(bf16 v) { return __builtin_bit_cast(float, (unsigned)v << 16); }
__device__ __forceinline__ float sigmoidf_(float x) { return 1.0f / (1.0f + __expf(-x)); }
typedef float f32x2_t __attribute__((ext_vector_type(2))); typedef __bf16 bf16x2_t __attribute__((ext_vector_type(2)));
__device__ __forceinline__ unsigned cvtpk(float lo, float hi) { f32x2_t v = {lo, hi}; bf16x2_t b = __builtin_convertvector(v, bf16x2_t); return __builtin_bit_cast(unsigned, b); }
__device__ __forceinline__ float frcp(float x) { return __builtin_amdgcn_rcpf(x); }
__device__ __forceinline__ float frsq(float x) { return __builtin_amdgcn_rsqf(x); }
__device__ __forceinline__ float fsigmoid(float x) { return __builtin_amdgcn_rcpf(1.0f + __expf(-x)); }
__device__ __forceinline__ float wave_sum_l(float v, int lane) {
#pragma unroll
    for (int o = 1; o < 64; o <<= 1) v += __builtin_bit_cast(float, __builtin_amdgcn_ds_bpermute((lane ^ o) << 2, __builtin_bit_cast(int, v)));
    return v;
}
#define LANE_SETUP int tid_ = threadIdx.x; asm volatile("" : "+v"(tid_)); const int tid = tid_, lane = tid & 63, wave = __builtin_amdgcn_readfirstlane(tid >> 6); (void)tid; (void)lane; (void)wave;
#define SHX(v, k) __builtin_bit_cast(float, __builtin_amdgcn_ds_bpermute(((lane) ^ (k)) << 2, __builtin_bit_cast(int, (float)(v))))
#define SHUP(v, o) __builtin_bit_cast(float, __builtin_amdgcn_ds_bpermute((((lane) >= (o)) ? (lane) - (o) : (lane)) << 2, __builtin_bit_cast(int, (float)(v))))
#define WSUM(v) wave_sum_l((v), lane)
__device__ __forceinline__ float gelu_tanh(float y) {
    const float z = 0.7978845608028654f * (y + 0.044715f * y * y * y);
    const float t = 1.0f - 2.0f * __builtin_amdgcn_rcpf(1.0f + __expf(2.0f * z));
    return 0.5f * y * (1.0f + t);
}

__device__ __forceinline__ void p0_transpose_item(const float* W, int K, int N, const float* ksc, bf16* WT, int dst_row0, LAS float* scr, int kb, int nb, int lane) {
    const int k0 = 64 * kb, n0 = 32 * nb;
    float tv[32];
#pragma unroll
    for (int i = 0; i < 32; ++i) { const int kk = 2 * i + (lane >> 5); tv[i] = W[(size_t)(k0 + kk) * N + n0 + (lane & 31)]; }
#pragma unroll
    for (int i = 0; i < 32; ++i) { const int kk = 2 * i + (lane >> 5); float v = tv[i]; if (ksc) v *= ksc[k0 + kk]; scr[kk * 33 + (lane & 31)] = v; }
    LDS_WAIT(); asm volatile("" ::: "memory");
    const int c = lane & 7;
#pragma unroll
    for (int j = 0; j < 4; ++j) { const int n = (lane >> 3) + 8 * j; const LAS float* s = scr + (8 * c) * 33 + n;
        v4u o; o.x = pk2(s[0 * 33], s[1 * 33]); o.y = pk2(s[2 * 33], s[3 * 33]); o.z = pk2(s[4 * 33], s[5 * 33]); o.w = pk2(s[6 * 33], s[7 * 33]);
        *(GAS v4u*)(WT + (size_t)(dst_row0 + n) * K + k0 + 8 * c) = o; }
    LDS_WAIT(); asm volatile("" ::: "memory");
}
__device__ __forceinline__ void weight_items(Frame& F, LAS float* scr, int first, int stride, int lo, int hi, int lane, gu32* ctr = nullptr) {
    constexpr int I_IN = 16 * 72, I_OUT = 16 * 32, I_G = 16 * 88, I_U = I_G, I_D = 44 * 32, I_GLU = 4 * 8, I_LAYER = I_IN + I_OUT + I_G + I_U + I_D + I_GLU;
    int sub = 8, qbase = 0;
    for (int it = lo + first;; it += stride) {
        if (ctr) { if (sub == 8) { unsigned t_ = 0u; if (lane == 0) t_ = __hip_atomic_fetch_add(ctr, 8u, RLX_AGENT); qbase = lo + (int)__builtin_amdgcn_readfirstlane(t_); sub = 0; }
            it = qbase + sub; ++sub; }
        if (it >= hi) break;
        const int l = it / I_LAYER; int r = it % I_LAYER;
        if (r < I_IN) { const int kb = r / 72, nb = r % 72; p0_transpose_item(F.in[2] + (size_t)l * D * DIN, D, DIN, F.in[1] + l * D, (bf16*)(F.ws + WS_WIN + l * WIN_STRIDE), 32 * nb, scr, kb, nb, lane); continue; } r -= I_IN;
        if (r < I_OUT) { const int kb = r / 32, nb = r % 32; p0_transpose_item(F.in[23] + (size_t)l * D * D, D, D, nullptr, (bf16*)(F.ws + WS_WOUT + l * WOUT_STRIDE), 32 * nb, scr, kb, nb, lane); continue; } r -= I_OUT;
        if (r < I_G) { const int kb = r / 88, nb = r % 88, n0 = 32 * nb; p0_transpose_item(F.in[25] + (size_t)l * D * DFF, D, DFF, F.in[24] + l * D, (bf16*)(F.ws + WS_WGU + l * WGU_STRIDE), 256 * (n0 / 128) + (n0 % 128), scr, kb, nb, lane); continue; } r -= I_G;
        if (r < I_U) { const int kb = r / 88, nb = r % 88, n0 = 32 * nb; p0_transpose_item(F.in[26] + (size_t)l * D * DFF, D, DFF, F.in[24] + l * D, (bf16*)(F.ws + WS_WGU + l * WGU_STRIDE), 256 * (n0 / 128) + 128 + (n0 % 128), scr, kb, nb, lane); continue; } r -= I_U;
        if (r < I_D) { const int kb = r / 32, nb = r % 32; p0_transpose_item(F.in[27] + (size_t)l * DFF * D, DFF, D, nullptr, (bf16*)(F.ws + WS_WD + l * WD_STRIDE), 32 * nb, scr, kb, nb, lane); continue; } r -= I_D;
        { const int kb = r / 8, nb = r % 8; p0_transpose_item(F.in[13] + (size_t)l * 256 * 256, 256, 256, nullptr, (bf16*)(F.ws + WS_WGLU + l * WGLU_STRIDE), 32 * nb, scr, kb, nb, lane); }
    }
}
constexpr int W_ITEMS_EARLY = 16 * 72, W_ITEMS_ALL = 2 * (16 * 72 + 16 * 32 + 2 * 16 * 88 + 44 * 32 + 4 * 8);
__device__ __forceinline__ void p0_prologue(Frame& F) {
    LANE_SETUP
    LAS float* scr = (LAS float*)(F.lds + RING_OFF + wave * 16384);
    const int gw = F.vcu * NWAVES + wave, NGW = F.G * NWAVES;
    weight_items(F, scr, gw, NGW, 0, W_ITEMS_EARLY, lane);
    {
        const int gt = (F.vcu * NWAVES + wave) * 64 + lane, NGT = F.G * NWAVES * 64;
        constexpr int PER_L = (1024 * 256 + 512 * 256) / 8;
        for (int it = gt; it < DEPTH * PER_L; it += NGT) {
            const int l = it / PER_L; int r = it % PER_L; const float* src; bf16* dst; float sc = 1.f; int n, k0;
            if (r < 1024 * 256 / 8) { n = r / 32; k0 = (r % 32) * 8; dst = (bf16*)(F.ws + WS_WQK + l * WQK_STRIDE) + (size_t)n * 256 + k0;
                if (n < 512) src = F.in[16]; else { src = F.in[17]; sc = 0.08838834764831845f; } }
            else { r -= 1024 * 256 / 8; n = r / 32; k0 = (r % 32) * 8; dst = (bf16*)(F.ws + WS_WV + l * WV_STRIDE) + (size_t)n * 256 + k0; src = F.in[18]; }
            const int hh = (n & 511) >> 7, e = n & 127;
            v4u o = (v4u){0u, 0u, 0u, 0u};
            if ((k0 >> 7) == (hh & 1)) { const float* s = src + ((size_t)(l * 4 + hh) * 128 + (k0 & 127)) * 128 + e;
                o.x = pk2(s[0] * sc, s[128] * sc); o.y = pk2(s[256] * sc, s[384] * sc); o.z = pk2(s[512] * sc, s[640] * sc); o.w = pk2(s[768] * sc, s[896] * sc); }
            *(GAS v4u*)dst = o;
        }
        if (gt < 512) { const int c = gt & 255; const float r0 = F.in[3][c], r1 = F.in[3][256 + c], mx = fmaxf(r0, r1), e0 = expf(r0 - mx), e1 = expf(r1 - mx);
            F.par[PAR_LBV + gt] = (gt < 256) ? 0.f : e1 / (e0 + e1); }
        for (int it = F.vcu * NWAVES + wave; it < 2 * DEPTH * 512; it += F.G * NWAVES) {
            const int which = it >> 10, l = (it >> 9) & 1, k = it & 511, hh = k >> 7, d = k & 127;
            const float* wg = F.in[19] + (size_t)l * 1536 * 8; float acc[8];
#pragma unroll
            for (int j = 0; j < 8; ++j) acc[j] = 0.f;
#pragma unroll
            for (int half = 0; half < 2; ++half) { const int e = lane + 64 * half; const size_t wo = ((size_t)(l * 4 + hh) * 128 + d) * 128 + e;
                if (which == 0) { const float q = F.in[16][wo], kk = F.in[17][wo] * 0.08838834764831845f;
                    const f32x4 a0 = *(const GAS f32x4*)(wg + (size_t)(hh * 128 + e) * 8), a1 = *(const GAS f32x4*)(wg + (size_t)(hh * 128 + e) * 8 + 4);
                    const f32x4 b0 = *(const GAS f32x4*)(wg + (size_t)(512 + hh * 128 + e) * 8), b1 = *(const GAS f32x4*)(wg + (size_t)(512 + hh * 128 + e) * 8 + 4);
#pragma unroll
                    for (int j = 0; j < 4; ++j) { acc[j] += q * a0[j] + kk * b0[j]; acc[4 + j] += q * a1[j] + kk * b1[j]; } }
                else { const float v = F.in[18][wo];
                    const f32x4 a0 = *(const GAS f32x4*)(wg + (size_t)(1024 + hh * 128 + e) * 8), a1 = *(const GAS f32x4*)(wg + (size_t)(1024 + hh * 128 + e) * 8 + 4);
#pragma unroll
                    for (int j = 0; j < 4; ++j) { acc[j] += v * a0[j]; acc[4 + j] += v * a1[j]; } } }
#pragma unroll
            for (int j = 0; j < 8; ++j) acc[j] = WSUM(acc[j]);
            if (lane < 8) { float v = acc[0];
#pragma unroll
                for (int j = 1; j < 8; ++j) v = (lane == j) ? acc[j] : v;
                F.par[(which == 0 ? PAR_G1 : PAR_G2) + (l * 512 + k) * 8 + lane] = v; }
        }
        if (gt < DEPTH * 16 * 64) { const int l = gt >> 10, g = (gt >> 6) & 15, p = gt & 63;
            const float lre = F.in[5][gt], lim = F.in[6][gt], dt = expf(F.in[7][l * 16 + g]);
            const float mag = expf(lre * dt), ang = lim * dt; const float ar = mag * cosf(ang), ai = mag * sinf(ang);
            const float den = lre * lre + lim * lim, nr = ar - 1.0f, ni = ai; const float cr = (nr * lre + ni * lim) / den, ci = (ni * lre - nr * lim) / den;
            F.par[PAR_S5A + gt * 2] = ar; F.par[PAR_S5A + gt * 2 + 1] = ai;
            for (int h = 0; h < 16; ++h) { const float br = F.in[8][(size_t)gt * 16 + h], bi = F.in[9][(size_t)gt * 16 + h];
                F.par[PAR_S5BB + gt * 32 + h] = cr * br - ci * bi; F.par[PAR_S5BB + gt * 32 + 16 + h] = cr * bi + ci * br; }
            (void)p; }
    }
    for (int m4 = gw; m4 < T / 4; m4 += NGW) {
        f32x4 v[4][4];
#pragma unroll
        for (int q = 0; q < 4; ++q) { const GAS f32x4* xr = (const GAS f32x4*)(F.in[0] + (size_t)(4 * m4 + q) * D) + lane;
#pragma unroll
            for (int j = 0; j < 4; ++j) v[q][j] = xr[64 * j]; }
#pragma unroll
        for (int q = 0; q < 4; ++q) { GAS unsigned long long* o8 = (GAS unsigned long long*)(F.XB + (size_t)(4 * m4 + q) * D) + lane; float s = 0.f;
#pragma unroll
            for (int j = 0; j < 4; ++j) { const f32x4 x = v[q][j]; s += (x.x * x.x + x.y * x.y) + (x.z * x.z + x.w * x.w);
                o8[64 * j] = (unsigned long long)pk2(x.x, x.y) | ((unsigned long long)pk2(x.z, x.w) << 32); }
            s = WSUM(s); if (lane < 16) F.ss0[(size_t)(4 * m4 + q) * 16 + lane] = lane == 0 ? s : 0.f; }
    }
}

__device__ __forceinline__ void prep_phase(Frame& F, int l) {
    LANE_SETUP
    const int gw = F.vcu * NWAVES + wave, NGW = F.G * NWAVES, c0 = lane * 8;
    const float* cw = F.in[14] + (size_t)l * 4 * 512; const float* cb = F.in[15] + l * 512;
    float g1[8][8], g2[8][8];
#pragma unroll
    for (int j = 0; j < 8; ++j)
#pragma unroll
        for (int q = 0; q < 2; ++q) { const f32x4 a1 = *(const GAS f32x4*)(F.par + PAR_G1 + (l * 512 + c0 + j) * 8 + 4 * q), a2 = *(const GAS f32x4*)(F.par + PAR_G2 + (l * 512 + c0 + j) * 8 + 4 * q);
            g1[j][4 * q] = a1.x; g1[j][4 * q + 1] = a1.y; g1[j][4 * q + 2] = a1.z; g1[j][4 * q + 3] = a1.w; g2[j][4 * q] = a2.x; g2[j][4 * q + 1] = a2.y; g2[j][4 * q + 2] = a2.z; g2[j][4 * q + 3] = a2.w; }
    const int gq = 4 * (lane >> 5) + 2 * ((lane >> 4) & 1) + ((lane >> 3) & 1); const float bgl = F.in[20][l * 8 + gq];
    float cwr[4][8], cbr[8];
#pragma unroll
    for (int j = 0; j < 8; ++j) { cbr[j] = cb[c0 + j];
#pragma unroll
        for (int k = 0; k < 4; ++k) cwr[k][j] = cw[k * 512 + c0 + j]; }
    constexpr int RUN = 8;
    for (int it = gw; it < T / RUN; it += NGW) {
        const int m0 = it * RUN, s0 = m0 & (SEQ - 1);
        v4u rw[RUN + 3];
#pragma unroll
        for (int i = 0; i < RUN + 3; ++i) { rw[i] = (v4u){0u, 0u, 0u, 0u}; if (s0 - 3 + i >= 0) rw[i] = *(const GAS v4u*)(F.P + (size_t)(m0 - 3 + i) * DIN + PC_MX + c0); }
#pragma unroll
        for (int t = 0; t < RUN; ++t) {
            const int m = m0 + t; float a[8], xm[8];
#pragma unroll
            for (int j = 0; j < 8; ++j) a[j] = cbr[j];
#pragma unroll
            for (int k = 0; k < 4; ++k) { const v4u w = rw[t + k];
                const float x[8] = {pg8::bf_lo(w.x), pg8::bf_hi(w.x), pg8::bf_lo(w.y), pg8::bf_hi(w.y), pg8::bf_lo(w.z), pg8::bf_hi(w.z), pg8::bf_lo(w.w), pg8::bf_hi(w.w)};
#pragma unroll
                for (int j = 0; j < 8; ++j) { a[j] += cwr[k][j] * x[j]; if (k == 3) xm[j] = x[j]; } }
#pragma unroll
            for (int j = 0; j < 8; ++j) a[j] = a[j] * fsigmoid(a[j]);
            { float ga[8];
#pragma unroll
              for (int q = 0; q < 8; ++q) { float v = 0.f;
#pragma unroll
                  for (int j = 0; j < 8; ++j) v += a[j] * g1[j][q] + xm[j] * g2[j][q];
                  ga[q] = v; }
              { const bool b5 = lane >= 32, b4 = (lane >> 4) & 1, b3 = (lane >> 3) & 1;
#pragma unroll
                for (int q = 0; q < 4; ++q) { const float snd = b5 ? ga[q] : ga[q + 4]; const float rcv = SHX(snd, 32); ga[q] = (b5 ? ga[q + 4] : ga[q]) + rcv; }
#pragma unroll
                for (int q = 0; q < 2; ++q) { const float snd = b4 ? ga[q] : ga[q + 2]; const float rcv = SHX(snd, 16); ga[q] = (b4 ? ga[q + 2] : ga[q]) + rcv; }
                { const float snd = b3 ? ga[0] : ga[1]; const float rcv = SHX(snd, 8); ga[0] = (b3 ? ga[1] : ga[0]) + rcv; }
                ga[0] += SHX(ga[0], 4); ga[0] += SHX(ga[0], 2); ga[0] += SHX(ga[0], 1); }
              if ((lane & 7) == 0) F.gates[(size_t)m * 8 + gq] = ga[0] + bgl; }
            v4u o; o.x = pk2(a[0], a[1]); o.y = pk2(a[2], a[3]); o.z = pk2(a[4], a[5]); o.w = pk2(a[6], a[7]);
            *(GAS v4u*)(F.XC + (size_t)m * 512 + c0) = o;
        }
    }
}
__device__ __forceinline__ void hgrn_prep_phase(Frame& F, int l) {
    LANE_SETUP
    const int gw = F.vcu * NWAVES + wave, NGW = F.G * NWAVES, tg = lane >> 3, cg = lane & 7;
    GAS float* hdec = (GAS float*)(F.ws + WS_HDEC);
    for (int it = gw; it < NB * 64 * 4; it += NGW) {
        const int h = it & 3, cn = it >> 2, ch0 = h * 64 + cg * 8;
        float lb[8];
#pragma unroll
        for (int j = 0; j < 8; ++j) lb[j] = F.par[PAR_LBV + l * 256 + ch0 + j];
        GAS bf16* base = F.P + (size_t)(cn * 32 + 4 * tg) * DIN + ch0;
        v4u qv[4], fv[4];
#pragma unroll
        for (int i = 0; i < 4; ++i) { qv[i] = *(const GAS v4u*)(base + (size_t)i * DIN + PC_Q); fv[i] = *(const GAS v4u*)(base + (size_t)i * DIN + PC_F); }
        float lf[4][8], kk[4][8], qs[4][8], pre[8];
#pragma unroll
        for (int i = 0; i < 4; ++i) {
            const float fr[8] = {pg8::bf_lo(fv[i].x), pg8::bf_hi(fv[i].x), pg8::bf_lo(fv[i].y), pg8::bf_hi(fv[i].y), pg8::bf_lo(fv[i].z), pg8::bf_hi(fv[i].z), pg8::bf_lo(fv[i].w), pg8::bf_hi(fv[i].w)};
            const float qr[8] = {pg8::bf_lo(qv[i].x), pg8::bf_hi(qv[i].x), pg8::bf_lo(qv[i].y), pg8::bf_hi(qv[i].y), pg8::bf_lo(qv[i].z), pg8::bf_hi(qv[i].z), pg8::bf_lo(qv[i].w), pg8::bf_hi(qv[i].w)};
#pragma unroll
            for (int j = 0; j < 8; ++j) { const float e = __expf(-fr[j]), rc = frcp(1.0f + e), omlb = 1.0f - lb[j];
                const float f = lb[j] + omlb * rc; kk[i][j] = omlb * e * rc; qs[i][j] = qr[j] * fsigmoid(qr[j]);
                lf[i][j] = __logf(f) + (i ? lf[i - 1][j] : 0.f); }
        }
#pragma unroll
        for (int j = 0; j < 8; ++j) { float s = lf[3][j];
#pragma unroll
            for (int o = 8; o < 64; o <<= 1) { const float v = SHUP(s, o); if (lane >= o) s += v; }
            pre[j] = s - lf[3][j]; }
#pragma unroll
        for (int i = 0; i < 4; ++i) { float oq[8], of[8];
#pragma unroll
            for (int j = 0; j < 8; ++j) { const float bt = pre[j] + lf[i][j], eb = __expf(bt); oq[j] = qs[i][j] * eb; of[j] = kk[i][j] * frcp(eb); }
            v4u wq, wf; wq.x = cvtpk(oq[0], oq[1]); wq.y = cvtpk(oq[2], oq[3]); wq.z = cvtpk(oq[4], oq[5]); wq.w = cvtpk(oq[6], oq[7]);
            wf.x = cvtpk(of[0], of[1]); wf.y = cvtpk(of[2], of[3]); wf.z = cvtpk(of[4], of[5]); wf.w = cvtpk(of[6], of[7]);
            *(GAS v4u*)(base + (size_t)i * DIN + PC_Q) = wq; *(GAS v4u*)(base + (size_t)i * DIN + PC_F) = wf; }
        if (tg == 7) { f32x4 d0, d1;
#pragma unroll
            for (int j = 0; j < 4; ++j) { d0[j] = __expf(pre[j] + lf[3][j]); d1[j] = __expf(pre[4 + j] + lf[3][4 + j]); }
            *(GAS f32x4*)(hdec + (size_t)cn * 256 + ch0) = d0; *(GAS f32x4*)(hdec + (size_t)cn * 256 + ch0 + 4) = d1; }
    }
}
__device__ __forceinline__ void final_phase(Frame& F) {
    LANE_SETUP
    const int gw = F.vcu * NWAVES + wave, NGW = F.G * NWAVES; const GAS float* ss = ss_arr(F, 4); const float* g = F.in[28];
    f32x4 gv[4];
#pragma unroll
    for (int j = 0; j < 4; ++j) gv[j] = *(const GAS f32x4*)(g + 256 * j + lane * 4);
#pragma unroll 4
    for (int m = gw; m < T; m += NGW) { const float rs = pg8::row_rs(ss, m);
        const GAS u32x2* xr = (const GAS u32x2*)(F.XB + (size_t)m * D) + lane; GAS f32x4* orow = (GAS f32x4*)(F.out + (size_t)m * D) + lane;
#pragma unroll
        for (int j = 0; j < 4; ++j) { const u32x2 w = xr[64 * j]; f32x4 v = (f32x4){pg8::bf_lo(w.x), pg8::bf_hi(w.x), pg8::bf_lo(w.y), pg8::bf_hi(w.y)}; v = v * rs * gv[j]; orow[64 * j] = v; } }
}

typedef float f32x16 __attribute__((ext_vector_type(16)));
typedef short v4i16_t __attribute__((ext_vector_type(4)));
#define MFMA32(a, b, c) __builtin_amdgcn_mfma_f32_32x32x16_bf16(a, b, c, 0, 0, 0)
__device__ __forceinline__ bf16x8 fragR(const LAS unsigned char* tile, int rs, int r0, int k0, int lane) {
    return *(const LAS bf16x8*)(tile + (r0 + (lane & 31)) * rs + (k0 + 8 * (lane >> 5)) * 2);
}
__device__ __forceinline__ bf16x8 fragT(const LAS unsigned char* tile, int rs, int k0, int n0, int lane) {
    const int hb = lane >> 5, g = (lane >> 4) & 1, q = (lane & 15) >> 2, p = lane & 3;
    const LAS unsigned char* a = tile + (k0 + 8 * hb + q) * rs + (n0 + 16 * g + 4 * p) * 2;
    const v4i16_t lo = __builtin_amdgcn_ds_read_tr16_b64_v4i16((LAS v4i16_t*)a);
    const v4i16_t hi = __builtin_amdgcn_ds_read_tr16_b64_v4i16((LAS v4i16_t*)(a + 4 * rs));
    return (bf16x8){lo[0], lo[1], lo[2], lo[3], hi[0], hi[1], hi[2], hi[3]};
}
__device__ __forceinline__ void storeT(LAS unsigned char* tile, int rs, int c0, int r0, const f32x16& a, int lane) {
    LAS unsigned char* p = tile + (c0 + (lane & 31)) * rs + (r0 + 4 * (lane >> 5)) * 2;
#pragma unroll
    for (int g = 0; g < 4; ++g) { u32x2 w; w.x = cvtpk(a[4 * g], a[4 * g + 1]); w.y = cvtpk(a[4 * g + 2], a[4 * g + 3]); *(LAS u32x2*)(p + 16 * g) = w; }
}
__device__ __forceinline__ bf16x8 pack8(const float* s, float sc) {
    v4u w; w.x = pk2(s[0] * sc, s[1] * sc); w.y = pk2(s[2] * sc, s[3] * sc); w.z = pk2(s[4] * sc, s[5] * sc); w.w = pk2(s[6] * sc, s[7] * sc); return __builtin_bit_cast(bf16x8, w);
}
#define ROW_OF(i, hb) (((i) & 3) + 8 * ((i) >> 2) + 4 * (hb))

__device__ __forceinline__ void s5_task(Frame& F, int l, int item, LAS unsigned char* wl) {
    LANE_SETUP
    const int seg = item & 1, bg_ = item >> 1, b = bg_ >> 4, g = bg_ & 15, lg = l * 16 + g, r = lane & 31, hb = lane >> 5;
    const int t_full = seg * (SEQ / 2), t_end = t_full + SEQ / 2;
    bf16x8 Bf[4], Cf[8];
#pragma unroll
    for (int ct = 0; ct < 4; ++ct) { const int p = (ct & 1) * 32 + r; Bf[ct] = pack8((const float*)F.par + PAR_S5BB + (lg * 64 + p) * 32 + (ct >> 1) * 16 + 8 * hb, 1.0f); }
#pragma unroll
    for (int ks = 0; ks < 8; ++ks) { const int c0 = 16 * ks + 8 * hb; const float* src = (c0 < 64 ? F.in[10] : F.in[11]) + ((size_t)lg * 16 + (r & 15)) * 64 + (c0 & 63);
        Cf[ks] = pack8(src, r < 16 ? (c0 < 64 ? 1.0f : -1.0f) : 0.0f); }
    const float ar = F.par[PAR_S5A + (lg * 64 + lane) * 2], ai = F.par[PAR_S5A + (lg * 64 + lane) * 2 + 1];
    const int et = lane >> 1, ehf = lane & 1;
    float dd[8];
#pragma unroll
    for (int j = 0; j < 8; ++j) dd[j] = F.in[12][l * 256 + g * 16 + 8 * ehf + j];
    LAS float* Ysc = (LAS float*)(wl + 10240);
    float xr = 0.f, xi = 0.f;
    const GAS bf16* Ub = F.P + (size_t)(b * SEQ) * DIN + PC_U + g * 16;
    const int tok = 16 * ((r >> 2) & 1) + (r & 3) + 4 * (r >> 3);
    bf16x8 Af = *(const GAS bf16x8*)(Ub + (size_t)tok * DIN + 8 * hb);
    v4u Uf = *(const GAS v4u*)(Ub + (size_t)et * DIN + 8 * ehf);
    for (int t0 = 0; t0 < t_end; t0 += 32) {
        const bf16x8 Acur = Af; const v4u Ucur = Uf; const bool full = t0 >= t_full;
        if (t0 + 32 < t_end) { Af = *(const GAS bf16x8*)(Ub + (size_t)(t0 + 32 + tok) * DIN + 8 * hb); Uf = *(const GAS v4u*)(Ub + (size_t)(t0 + 32 + et) * DIN + 8 * ehf); }
        f32x16 acc[4];
#pragma unroll
        for (int ct = 0; ct < 4; ++ct) { f32x16 z; for (int i = 0; i < 16; ++i) z[i] = 0.f; acc[ct] = MFMA32(Acur, Bf[ct], z); }
#pragma unroll
        for (int pr = 0; pr < 2; ++pr)
#pragma unroll
            for (int i = 0; i < 16; ++i) { auto rr = __builtin_amdgcn_permlane32_swap(__float_as_uint(acc[2 * pr][i]), __float_as_uint(acc[2 * pr + 1][i]), false, false);
                acc[2 * pr][i] = __uint_as_float(rr[0]); acc[2 * pr + 1][i] = __uint_as_float(rr[1]); }
#pragma unroll
        for (int hf = 0; hf < 2; ++hf)
#pragma unroll
            for (int i = 0; i < 16; ++i) { const float nr = ar * xr - ai * xi + acc[hf][i], ni = ar * xi + ai * xr + acc[2 + hf][i]; xr = nr; xi = ni; acc[hf][i] = nr; acc[2 + hf][i] = ni; }
        if (!full) continue;
#pragma unroll
        for (int part = 0; part < 2; ++part)
#pragma unroll
            for (int q4 = 0; q4 < 4; ++q4) { const f32x16& a = acc[2 * part + (q4 >> 1)]; const int o = (q4 & 1) * 8;
                v4u w; w.x = cvtpk(a[o + 0], a[o + 1]); w.y = cvtpk(a[o + 2], a[o + 3]); w.z = cvtpk(a[o + 4], a[o + 5]); w.w = cvtpk(a[o + 6], a[o + 7]);
                *(LAS v4u*)(wl + (part * 64 + lane) * 80 + q4 * 16) = w; }
        LDS_WAIT(); __builtin_amdgcn_wave_barrier();
        f32x16 y; for (int i = 0; i < 16; ++i) y[i] = 0.f;
#pragma unroll
        for (int ks = 0; ks < 8; ++ks) y = MFMA32(fragT(wl, 80, 16 * ks, 0, lane), Cf[ks], y);
        if (r < 16) {
#pragma unroll
            for (int i = 0; i < 16; ++i) Ysc[ROW_OF(i, hb) * 16 + r] = y[i];
        }
        LDS_WAIT(); __builtin_amdgcn_wave_barrier();
        { const f32x4 ya = *(const LAS f32x4*)(Ysc + et * 16 + 8 * ehf), yb = *(const LAS f32x4*)(Ysc + et * 16 + 8 * ehf + 4);
          float o[8];
          o[0] = gelu_tanh(ya.x + dd[0] * pg8::bf_lo(Ucur.x)); o[1] = gelu_tanh(ya.y + dd[1] * pg8::bf_hi(Ucur.x)); o[2] = gelu_tanh(ya.z + dd[2] * pg8::bf_lo(Ucur.y)); o[3] = gelu_tanh(ya.w + dd[3] * pg8::bf_hi(Ucur.y));
          o[4] = gelu_tanh(yb.x + dd[4] * pg8::bf_lo(Ucur.z)); o[5] = gelu_tanh(yb.y + dd[5] * pg8::bf_hi(Ucur.z)); o[6] = gelu_tanh(yb.z + dd[6] * pg8::bf_lo(Ucur.w)); o[7] = gelu_tanh(yb.w + dd[7] * pg8::bf_hi(Ucur.w));
          v4u w4; w4.x = cvtpk(o[0], o[1]); w4.y = cvtpk(o[2], o[3]); w4.z = cvtpk(o[4], o[5]); w4.w = cvtpk(o[6], o[7]);
          *(GAS v4u*)(F.YS5 + (size_t)(b * SEQ + t0 + et) * 256 + g * 16 + 8 * ehf) = w4; }
        LDS_WAIT(); __builtin_amdgcn_wave_barrier();
    }
}


__device__ __forceinline__ void hgrn_task(Frame& F, int l, int item, LAS unsigned char* wl) {
    LANE_SETUP
    const int seg = item & 1, bh_ = item >> 1, b = bh_ >> 2, h = bh_ & 3, r = lane & 31, hb = lane >> 5;
    const int t_full = seg * (SEQ / 2), t_end = t_full + SEQ / 2;
    const int et = lane & 31, ehf = lane >> 5;
    constexpr int RS = 144, TSZ = 32 * RS;
    LAS unsigned char *Tq = wl, *Tf = wl + TSZ, *Ti = wl + 2 * TSZ, *Tg = wl + 3 * TSZ, *SC = wl + 4 * TSZ, *ST = SC + 2560;
    LAS float* dec = (LAS float*)(ST + 64 * RS);
    { unsigned z0 = 0u; asm volatile("" : "+v"(z0));
      for (int i = lane; i < 64 * RS / 16; i += 64) *(LAS v4u*)(ST + i * 16) = (v4u){z0, z0, z0, z0}; }
    f32x16 S[2][2];
#pragma unroll
    for (int db = 0; db < 2; ++db)
#pragma unroll
        for (int eb = 0; eb < 2; ++eb) for (int i = 0; i < 16; ++i) S[db][eb][i] = 0.f;
    const int lt = lane >> 3, lc = lane & 7;
    const GAS bf16* Pb = F.P + (size_t)(b * SEQ) * DIN + h * 64 + lc * 8;
    const float* hdec = (const float*)(F.ws + WS_HDEC) + (size_t)(b * 64) * 256 + h * 64 + lane;
    v4u pre[3][4];
#pragma unroll
    for (int a = 0; a < 3; ++a)
#pragma unroll
        for (int k = 0; k < 4; ++k) pre[a][k] = *(const GAS v4u*)(Pb + (size_t)(lt + 8 * k) * DIN + a * 256);
    float dpre = hdec[0];
    for (int t0 = 0; t0 < t_end; t0 += 32) {
        const bool full = t0 >= t_full;
#pragma unroll
        for (int a = 0; a < 3; ++a)
#pragma unroll
            for (int k = 0; k < 4; ++k) *(LAS v4u*)(wl + a * TSZ + (lt + 8 * k) * RS + lc * 16) = pre[a][k];
        dec[lane] = dpre;
        if (t0 + 32 < t_end) {
#pragma unroll
            for (int a = 0; a < 3; ++a)
#pragma unroll
                for (int k = 0; k < 4; ++k) pre[a][k] = *(const GAS v4u*)(Pb + (size_t)(t0 + 32 + lt + 8 * k) * DIN + a * 256);
            dpre = hdec[(size_t)((t0 >> 5) + 1) * 256];
        }
        LDS_WAIT(); __builtin_amdgcn_wave_barrier();
        f32x16 O[2];
        if (full) {
        f32x16 X; for (int i = 0; i < 16; ++i) X[i] = 0.f;
#pragma unroll
        for (int ks = 0; ks < 4; ++ks) X = MFMA32(fragR(Tf, RS, 0, 16 * ks, lane), fragR(Tq, RS, 0, 16 * ks, lane), X);
#pragma unroll
        for (int i = 0; i < 16; ++i) if (ROW_OF(i, hb) > r) X[i] = 0.f;
        storeT(SC, 80, 0, 0, X, lane);
        LDS_WAIT(); __builtin_amdgcn_wave_barrier();
#pragma unroll
        for (int eb = 0; eb < 2; ++eb) { for (int i = 0; i < 16; ++i) O[eb][i] = 0.f;
#pragma unroll
            for (int ks = 0; ks < 2; ++ks) O[eb] = MFMA32(fragR(SC, 80, 0, 16 * ks, lane), fragT(Ti, RS, 16 * ks, 32 * eb, lane), O[eb]);
#pragma unroll
            for (int ks = 0; ks < 4; ++ks) O[eb] = MFMA32(fragR(Tq, RS, 0, 16 * ks, lane), fragR(ST, RS, 32 * eb, 16 * ks, lane), O[eb]); }
        }
#pragma unroll
        for (int db = 0; db < 2; ++db)
#pragma unroll
            for (int eb = 0; eb < 2; ++eb)
#pragma unroll
                for (int ks = 0; ks < 2; ++ks) S[db][eb] = MFMA32(fragT(Tf, RS, 16 * ks, 32 * db, lane), fragT(Ti, RS, 16 * ks, 32 * eb, lane), S[db][eb]);
        LDS_WAIT(); __builtin_amdgcn_wave_barrier();
#pragma unroll
        for (int db = 0; db < 2; ++db) {
#pragma unroll
            for (int i = 0; i < 16; ++i) { const float d = dec[32 * db + ROW_OF(i, hb)]; S[db][0][i] *= d; S[db][1][i] *= d; }
            storeT(ST, RS, 0, 32 * db, S[db][0], lane); storeT(ST, RS, 32, 32 * db, S[db][1], lane); }
        LDS_WAIT(); __builtin_amdgcn_wave_barrier();
        if (full) { LAS float* Of = (LAS float*)wl;
#pragma unroll
          for (int eb = 0; eb < 2; ++eb)
#pragma unroll
              for (int i = 0; i < 16; ++i) Of[ROW_OF(i, hb) * 68 + 32 * eb + r] = O[eb][i];
          LDS_WAIT(); __builtin_amdgcn_wave_barrier();
          GAS bf16* op = F.MIX + (size_t)(b * SEQ + t0 + et) * 1024 + h * 64 + 32 * ehf;
#pragma unroll
          for (int c4 = 0; c4 < 4; ++c4) { const f32x4 va = *(const LAS f32x4*)(Of + et * 68 + 32 * ehf + 8 * c4), vb = *(const LAS f32x4*)(Of + et * 68 + 32 * ehf + 8 * c4 + 4);
              v4u w4; w4.x = cvtpk(va.x, va.y); w4.y = cvtpk(va.z, va.w); w4.z = cvtpk(vb.x, vb.y); w4.w = cvtpk(vb.z, vb.w);
              *(GAS v4u*)(op + 8 * c4) = w4; } }
        LDS_WAIT(); __builtin_amdgcn_wave_barrier();
    }
}


__device__ __forceinline__ void mlstm_task(Frame& F, int l, int item) {
    LANE_SETUP
    const int seg = item & 1, bh_ = item >> 1, b = bh_ >> 2, h = bh_ & 3, w = wave, r = lane & 31, hb = lane >> 5;
    const int n_full = seg * 16, n_end = n_full + 16;
    constexpr int RS = 272, TS = 64 * RS;
    constexpr int RST = 320, TST = 64 * RST;
    LAS unsigned char *Qt = F.lds, *Kt = Qt + TS, *Kw = Kt + TS, *Vt = Kw + TST, *Wt = Vt + TST, *CT = Wt + 64 * 144, *Hs = Kt;
    LAS float* gLF = (LAS float*)(CT + 128 * RS);
    LAS float* gIG = gLF + 1024;
    LAS float* gGM = (LAS float*)(F.lds + LDSCTL_OFF + 6144);
    LAS float* dnp = (LAS float*)(F.lds + LDSCTL_OFF + 10240);
    LAS float* sc_ = (LAS float*)(F.lds + LDSCTL_OFF + 1024);
    LAS float *sA = sc_, *sM = sc_ + 128, *sW = sc_ + 256, *sSC = sc_ + 384, *sEM = sc_ + 512, *sSP = sc_ + 640, *RSUM = sc_ + 648, *QN = sc_ + 776, *nbuf = sc_ + 840, *cstat = sc_ + 1096;
    { unsigned z0 = 0u; asm volatile("" : "+v"(z0));
      for (int i = tid; i < 128 * RS / 16; i += 512) *(LAS v4u*)(CT + i * 16) = (v4u){z0, z0, z0, z0};
      if (tid < 256) nbuf[tid] = __uint_as_float(z0); }
    f32x16 C[2];
#pragma unroll
    for (int j = 0; j < 2; ++j) for (int i = 0; i < 16; ++i) C[j][i] = 0.f;
    float m_prev = 0.f;
    const int lrow = tid >> 3, lc16 = (tid & 7) * 2;
    const int tb = w >> 2, eb = w & 3;
    const GAS bf16* Qg = F.QKV + (size_t)(b * SEQ) * 1536 + h * 128;
    const GAS float* gg = F.gates + (size_t)(b * SEQ) * 8;
    LAS float* pLF = (LAS float*)(Qt);
    LAS float* pIG = pLF + 1024;
    for (int t = tid; t < 1024; t += 512) { const GAS float* gp = gg + (size_t)(n_full * 64 + t) * 8; const float fg = gp[4 + h]; gLF[t] = fminf(fg, 0.f) - log1pf(__expf(-fabsf(fg))); gIG[t] = gp[h]; }
    if (seg) for (int t = tid; t < 1024; t += 512) { const GAS float* gp = gg + (size_t)t * 8; const float fg = gp[4 + h]; pLF[t] = fminf(fg, 0.f) - log1pf(__expf(-fabsf(fg))); pIG[t] = gp[h]; }
    v4u pq[2], pk[2], pv[2];
#pragma unroll
    for (int j = 0; j < 2; ++j) { const GAS bf16* s = Qg + (size_t)lrow * 1536 + (lc16 + j) * 8; pq[j] = *(const GAS v4u*)s; pk[j] = *(const GAS v4u*)(s + 512); pv[j] = *(const GAS v4u*)(s + 1024); }
    __syncthreads();
    if (seg) {
        float bloc[2], igv[2];
#pragma unroll
        for (int c2 = 0; c2 < 2; ++c2) { const int c = 2 * w + c2; float bc = pLF[c * 64 + lane]; igv[c2] = pIG[c * 64 + lane];
#pragma unroll
            for (int o = 1; o < 64; o <<= 1) { const float v = SHUP(bc, o); if (lane >= o) bc += v; }
            bloc[c2] = bc; if (lane == 63) cstat[c] = bc; }
        __syncthreads();
        float Btot = 0.f, off0 = 0.f, off1 = 0.f;
#pragma unroll
        for (int c = 0; c < 16; ++c) { const float v = cstat[c]; if (c < 2 * w) off0 += v; if (c < 2 * w + 1) off1 += v; Btot += v; }
        float amax;
        { const float a0 = igv[0] - (bloc[0] + off0), a1 = igv[1] - (bloc[1] + off1);
          gGM[(2 * w) * 64 + lane] = a0; gGM[(2 * w + 1) * 64 + lane] = a1;
          float mx = fmaxf(a0, a1);
#pragma unroll
          for (int o = 1; o < 64; o <<= 1) mx = fmaxf(mx, SHX(mx, o));
          if (lane == 0) cstat[16 + w] = mx; }
        __syncthreads();
        amax = cstat[16];
#pragma unroll
        for (int c = 1; c < 8; ++c) amax = fmaxf(amax, cstat[16 + c]);
        const float m16 = Btot + fmaxf(0.f, amax), wofs = Btot - m16;
        m_prev = m16;
        float na0 = 0.f, na1 = 0.f;
        for (int n = 0; n < 16; ++n) {
            LAS unsigned char* Kb = (n & 1) ? Qt : Kw; LAS unsigned char* Vb = (n & 1) ? Wt : Vt;
            { const float wrow = __expf(gGM[n * 64 + lrow] + wofs);
#pragma unroll
              for (int j = 0; j < 2; ++j) { const int o = lrow * RST + (lc16 + j) * 16;
                  *(LAS v4u*)(Vb + o) = pv[j];
                  v4u kw; kw.x = pk2(pg8::bf_lo(pk[j].x) * wrow, pg8::bf_hi(pk[j].x) * wrow); kw.y = pk2(pg8::bf_lo(pk[j].y) * wrow, pg8::bf_hi(pk[j].y) * wrow);
                  kw.z = pk2(pg8::bf_lo(pk[j].z) * wrow, pg8::bf_hi(pk[j].z) * wrow); kw.w = pk2(pg8::bf_lo(pk[j].w) * wrow, pg8::bf_hi(pk[j].w) * wrow);
                  *(LAS v4u*)(Kb + o) = kw; } }
            __syncthreads();
#pragma unroll
            for (int j = 0; j < 2; ++j) { const GAS bf16* s = Qg + (size_t)((n + 1) * 64 + lrow) * 1536 + (lc16 + j) * 8; pq[j] = *(const GAS v4u*)s; pk[j] = *(const GAS v4u*)(s + 512); pv[j] = *(const GAS v4u*)(s + 1024); }
#pragma unroll
            for (int s = 0; s < 8; ++s) { const unsigned kv = *(const LAS unsigned*)(Kb + (8 * w + s) * RST + lane * 4); na0 += pg8::bf_lo(kv); na1 += pg8::bf_hi(kv); }
#pragma unroll
            for (int j = 0; j < 2; ++j) { const int db = 2 * tb + j;
#pragma unroll
                for (int ks = 0; ks < 4; ++ks) C[j] = MFMA32(fragT(Kb, RST, 16 * ks, 32 * db, lane), fragT(Vb, RST, 16 * ks, 32 * eb, lane), C[j]); }
        }
        __syncthreads();
        dnp[w * 128 + 2 * lane] = na0; dnp[w * 128 + 2 * lane + 1] = na1;
        __syncthreads();
        if (w == 5) { float s0 = 0.f, s1 = 0.f;
#pragma unroll
            for (int q = 0; q < 8; ++q) { s0 += dnp[q * 128 + 2 * lane]; s1 += dnp[q * 128 + 2 * lane + 1]; }
            nbuf[2 * lane] = s0; nbuf[2 * lane + 1] = s1; }
#pragma unroll
        for (int j = 0; j < 2; ++j) storeT(CT, RS, 32 * eb, 32 * (2 * tb + j), C[j], lane);
        __syncthreads();
    }
    { if (seg) __syncthreads();
#pragma unroll
      for (int c2 = 0; c2 < 2; ++c2) { const int c = 2 * w + c2; float bc = gLF[c * 64 + lane]; const float ig = gIG[c * 64 + lane];
#pragma unroll
          for (int o = 1; o < 64; o <<= 1) { const float v = SHUP(bc, o); if (lane >= o) bc += v; }
          const float ap = ig - bc; float gm = ap;
#pragma unroll
          for (int o = 1; o < 64; o <<= 1) { const float v = SHUP(gm, o); if (lane >= o) gm = fmaxf(gm, v); }
          gLF[c * 64 + lane] = bc; gIG[c * 64 + lane] = ap; gGM[c * 64 + lane] = gm; }
      __syncthreads(); }
#define MLSTM_SCALARS(nn) do { const int nb_ = (nn) & 1, cl_ = ((nn) - n_full) * 64; const float bc = gLF[cl_ + lane], ap = gIG[cl_ + lane], gm = gGM[cl_ + lane], blast = gLF[cl_ + 63], g63 = gGM[cl_ + 63]; \
        const float M = fmaxf(gm, m_prev), mt = bc + M, m_new = fmaxf(blast + m_prev, blast + g63); \
        sA[nb_ * 64 + lane] = ap; sM[nb_ * 64 + lane] = M; sW[nb_ * 64 + lane] = __expf(blast + ap - m_new); sSC[nb_ * 64 + lane] = __expf(m_prev - M); sEM[nb_ * 64 + lane] = __expf(-mt); \
        if (lane == 0) sSP[nb_] = __expf(blast + m_prev - m_new); m_prev = m_new; } while (0)
    if (w == 7) MLSTM_SCALARS(n_full);
    __syncthreads();
    for (int n = n_full; n < n_end; ++n) {
        const int buf = n & 1, t0 = n * 64; const bool more = (n + 1 < n_end);
        const float sp = sSP[buf];
        { const float wrow = sW[buf * 64 + lrow];
#pragma unroll
          for (int j = 0; j < 2; ++j) { const int o = lrow * RS + (lc16 + j) * 16, ot = lrow * RST + (lc16 + j) * 16;
              *(LAS v4u*)(Qt + o) = pq[j]; *(LAS v4u*)(Kt + o) = pk[j]; *(LAS v4u*)(Vt + ot) = pv[j];
              v4u kw; kw.x = pk2(pg8::bf_lo(pk[j].x) * wrow, pg8::bf_hi(pk[j].x) * wrow); kw.y = pk2(pg8::bf_lo(pk[j].y) * wrow, pg8::bf_hi(pk[j].y) * wrow);
              kw.z = pk2(pg8::bf_lo(pk[j].z) * wrow, pg8::bf_hi(pk[j].z) * wrow); kw.w = pk2(pg8::bf_lo(pk[j].w) * wrow, pg8::bf_hi(pk[j].w) * wrow);
              *(LAS v4u*)(Kw + ot) = kw; } }
        __syncthreads();
        if (more) {
#pragma unroll
            for (int j = 0; j < 2; ++j) { const GAS bf16* s = Qg + (size_t)(t0 + 64 + lrow) * 1536 + (lc16 + j) * 8; pq[j] = *(const GAS v4u*)s; pk[j] = *(const GAS v4u*)(s + 512); pv[j] = *(const GAS v4u*)(s + 1024); }
        }
        if (w == 7 && more) MLSTM_SCALARS(n + 1);
        const LAS float* nold = nbuf + buf * 128;
        {
          const float n0_ = nold[2 * lane], n1_ = nold[2 * lane + 1]; float a0 = 0.f, a1 = 0.f, qd[8];
#pragma unroll
          for (int s = 0; s < 8; ++s) { const unsigned kv = *(const LAS unsigned*)(Kw + (8 * w + s) * RST + lane * 4), qv = *(const LAS unsigned*)(Qt + (8 * w + s) * RS + lane * 4);
              a0 += pg8::bf_lo(kv); a1 += pg8::bf_hi(kv); qd[s] = pg8::bf_lo(qv) * n0_ + pg8::bf_hi(qv) * n1_; }
          dnp[w * 128 + 2 * lane] = a0; dnp[w * 128 + 2 * lane + 1] = a1;
#pragma unroll
          for (int o = 1; o < 64; o <<= 1)
#pragma unroll
              for (int s = 0; s < 8; ++s) qd[s] += SHX(qd[s], o);
          if (lane < 8) { float v = qd[0];
#pragma unroll
              for (int s = 1; s < 8; ++s) v = (lane == s) ? qd[s] : v;
              QN[8 * w + lane] = v; } }
        f32x16 num; for (int i = 0; i < 16; ++i) num[i] = 0.f;
        if (w < 4) {
            const int sb = w >> 1, xtb = w & 1;
            f32x16 X; for (int i = 0; i < 16; ++i) X[i] = 0.f;
            if (w != 2) {
#pragma unroll
                for (int ks = 0; ks < 8; ++ks) X = MFMA32(fragR(Kt, RS, 32 * sb, 16 * ks, lane), fragR(Qt, RS, 32 * xtb, 16 * ks, lane), X);
            }
            const int tcol = 32 * xtb + r; const float Mt = sM[buf * 64 + tcol]; float ps = 0.f;
#pragma unroll
            for (int i = 0; i < 16; ++i) { const int s = 32 * sb + ROW_OF(i, hb); const float d = (s <= tcol) ? __expf(sA[buf * 64 + s] - Mt) : 0.f; X[i] *= d; ps += X[i]; }
            ps += SHX(ps, 32);
            if (hb == 0) RSUM[sb * 64 + tcol] = ps;
            storeT(Wt, 144, 32 * xtb, 32 * sb, X, lane);
        } else {
#pragma unroll
            for (int ks = 0; ks < 8; ++ks) num = MFMA32(fragR(Qt, RS, 32 * tb, 16 * ks, lane), fragR(CT, RS, 32 * eb, 16 * ks, lane), num);
        }
        __syncthreads();
        if (w < 4) {
#pragma unroll
            for (int ks = 0; ks < 8; ++ks) num = MFMA32(fragR(Qt, RS, 32 * tb, 16 * ks, lane), fragR(CT, RS, 32 * eb, 16 * ks, lane), num);
        }
#pragma unroll
        for (int i = 0; i < 16; ++i) num[i] *= sSC[buf * 64 + 32 * tb + ROW_OF(i, hb)];
#pragma unroll
        for (int ks = 0; ks < 4; ++ks) num = MFMA32(fragR(Wt, 144, 32 * tb, 16 * ks, lane), fragT(Vt, RST, 16 * ks, 32 * eb, lane), num);
#pragma unroll
        for (int i = 0; i < 16; ++i) { const int t = 32 * tb + ROW_OF(i, hb); const float den = RSUM[t] + RSUM[64 + t] + sSC[buf * 64 + t] * QN[t];
            const float hv = num[i] * frcp(fmaxf(fabsf(den), sEM[buf * 64 + t]));
            *((LAS bf16*)(Hs + t * RS) + 32 * eb + r) = (bf16)f2bf(hv); }
        __syncthreads();
#pragma unroll
        for (int j = 0; j < 2; ++j) { const int db = 2 * tb + j;
#pragma unroll
            for (int i = 0; i < 16; ++i) C[j][i] *= sp;
#pragma unroll
            for (int ks = 0; ks < 4; ++ks) C[j] = MFMA32(fragT(Kw, RST, 16 * ks, 32 * db, lane), fragT(Vt, RST, 16 * ks, 32 * eb, lane), C[j]);
            if (more) storeT(CT, RS, 32 * eb, 32 * db, C[j], lane); }
        if (w == 5) { float s0 = 0.f, s1 = 0.f;
#pragma unroll
            for (int q = 0; q < 8; ++q) { s0 += dnp[q * 128 + 2 * lane]; s1 += dnp[q * 128 + 2 * lane + 1]; }
            LAS float* nnew = nbuf + (buf ^ 1) * 128;
            nnew[2 * lane] = sp * nold[2 * lane] + s0; nnew[2 * lane + 1] = sp * nold[2 * lane + 1] + s1; }
#pragma unroll
        for (int j = 0; j < 8; ++j) { const int t = 8 * w + j; const unsigned hv = *(const LAS unsigned*)(Hs + t * RS + lane * 4);
            *(GAS unsigned*)(F.MIX + (size_t)(b * SEQ + t0 + t) * 1024 + 512 + h * 128 + 2 * lane) = hv; }
        __syncthreads();
    }
#undef MLSTM_SCALARS
}

__device__ __forceinline__ void post_phase(Frame& F, int l, int wg0) {
    LANE_SETUP
    const int nwg = F.G - wg0, me = (int)blockIdx.x - wg0;
    if (me < 0 || nwg <= 0) return;
    const int gw = me * NWAVES + wave, NGW = nwg * NWAVES;
    const f32x4 hng = *(const GAS f32x4*)(F.in[4] + l * 256 + 4 * lane);
    const f32x4 mnga = *(const GAS f32x4*)(F.in[21] + l * 512 + 8 * lane), mngb = *(const GAS f32x4*)(F.in[21] + l * 512 + 8 * lane + 4);
    const f32x4 mska = *(const GAS f32x4*)(F.in[22] + l * 512 + 8 * lane), mskb = *(const GAS f32x4*)(F.in[22] + l * 512 + 8 * lane + 4);
#pragma unroll 4
    for (int m = gw; m < T; m += NGW) {
        GAS bf16* mr = F.MIX + (size_t)m * 1024;
        const u32x2 hv = *(const GAS u32x2*)(mr + 4 * lane), hg = *(const GAS u32x2*)(F.P + (size_t)m * DIN + PC_G + 4 * lane);
        const v4u mv = *(const GAS v4u*)(mr + 512 + 8 * lane), mx = *(const GAS v4u*)(F.XC + (size_t)m * 512 + 8 * lane), mz = *(const GAS v4u*)(F.P + (size_t)m * DIN + PC_MZ + 8 * lane);
        { float v[4] = {pg8::bf_lo(hv.x), pg8::bf_hi(hv.x), pg8::bf_lo(hv.y), pg8::bf_hi(hv.y)}; const float g[4] = {pg8::bf_lo(hg.x), pg8::bf_hi(hg.x), pg8::bf_lo(hg.y), pg8::bf_hi(hg.y)};
          float ss = (v[0] * v[0] + v[1] * v[1]) + (v[2] * v[2] + v[3] * v[3]);
          ss += SHX(ss, 1); ss += SHX(ss, 2); ss += SHX(ss, 4); ss += SHX(ss, 8);
          const float rs = frsq(ss * (1.0f / 64.0f) + EPS);
#pragma unroll
          for (int j = 0; j < 4; ++j) v[j] = v[j] * rs * hng[j] * g[j] * fsigmoid(g[j]);
          u32x2 o; o.x = cvtpk(v[0], v[1]); o.y = cvtpk(v[2], v[3]); *(GAS u32x2*)(mr + 4 * lane) = o; }
        { float v[8] = {pg8::bf_lo(mv.x), pg8::bf_hi(mv.x), pg8::bf_lo(mv.y), pg8::bf_hi(mv.y), pg8::bf_lo(mv.z), pg8::bf_hi(mv.z), pg8::bf_lo(mv.w), pg8::bf_hi(mv.w)};
          const float x[8] = {pg8::bf_lo(mx.x), pg8::bf_hi(mx.x), pg8::bf_lo(mx.y), pg8::bf_hi(mx.y), pg8::bf_lo(mx.z), pg8::bf_hi(mx.z), pg8::bf_lo(mx.w), pg8::bf_hi(mx.w)};
          const float z[8] = {pg8::bf_lo(mz.x), pg8::bf_hi(mz.x), pg8::bf_lo(mz.y), pg8::bf_hi(mz.y), pg8::bf_lo(mz.z), pg8::bf_hi(mz.z), pg8::bf_lo(mz.w), pg8::bf_hi(mz.w)};
          float ss = 0.f;
#pragma unroll
          for (int j = 0; j < 8; ++j) ss += v[j] * v[j];
          ss += SHX(ss, 1); ss += SHX(ss, 2); ss += SHX(ss, 4); ss += SHX(ss, 8);
          const float rs = frsq(ss * (1.0f / 128.0f) + EPS);
#pragma unroll
          for (int j = 0; j < 8; ++j) { const float ngj = j < 4 ? mnga[j & 3] : mngb[j & 3], skj = j < 4 ? mska[j & 3] : mskb[j & 3]; v[j] = (v[j] * rs * ngj + skj * x[j]) * (z[j] * fsigmoid(z[j])); }
          v4u o; o.x = cvtpk(v[0], v[1]); o.y = cvtpk(v[2], v[3]); o.z = cvtpk(v[4], v[5]); o.w = cvtpk(v[6], v[7]); *(GAS v4u*)(mr + 512 + 8 * lane) = o; }
    }
}

__device__ __forceinline__ void mixers_phase(Frame& F, int l) {
    LANE_SETUP
    const int bid = F.vcu;
    if (F.G != 256) return;
    if (bid < 128) { mlstm_task(F, l, bid); return; }
    LAS unsigned char* myl = wave == 0 ? F.lds + RING_OFF : wave < 5 ? F.lds + RING_OFF + 32768 + (wave - 1) * 16384 : F.lds + RING_OFF + 98304 + (wave - 5) * 10240;
    if (wave == 0) hgrn_task(F, l, bid - 128, myl);
    else if (wave < 5) s5_task(F, l, (bid - 128) * 4 + (wave - 1), myl);
    if (l == 0) weight_items(F, (LAS float*)myl, 0, 1, W_ITEMS_EARLY, W_ITEMS_ALL, lane, F.ctl + CW_WCTR);
    { XcdBarrier bar2; bar2.bar = (unsigned*)(F.ctl + CW_BAR) + XCD_BAR_WORDS; bar2.x = xb_xcc_id(); bar2.st = F.MISC + 10; bar2.gexp = 128u; xcd_barrier(bar2); }
    { pg8::Gemm g{(const bf16*)F.YS5, (const bf16*)(F.ws + WS_WGLU + l * WGLU_STRIDE), T, 256, 256, 256, 0, 0}; pg8::StaticOrder S; S.init(T, 256, 128, bid - 128);
      pg8::EpiGlu E{F.YS5, F.MIX, 1024, 256};
      pg8::gemm_phase<pg8::EpiGlu, pg8::StaticOrder, true, true>(F.lds + RING_OFF, g, S, E); }
}

struct Args { const float* in[29]; float* out; unsigned char* ws; int ph_lo, ph_hi; };
__global__ void __launch_bounds__(NWAVES * 64, 2) fwd_kernel(Args args) {
    extern __shared__ __attribute__((aligned(16))) unsigned char lds[];
    Frame F;
    F.lds = (LAS unsigned char*)lds;
    F.MISC = (volatile LAS unsigned*)(F.lds + MISC_OFF);
    F.G = gridDim.x; { const int bx = blockIdx.x; F.vcu = (F.G % 8 == 0) ? (bx % 8) * (F.G / 8) + bx / 8 : bx; }
    GAS unsigned char* ws = (GAS unsigned char*)args.ws;
#define SET_WS() do { asm volatile("" : "+s"(ws)); F.ws = ws; F.par = (GAS float*)(ws + WS_PAR); F.ss0 = (GAS float*)(ws + WS_SS); F.gates = (GAS float*)(ws + WS_GATES); \
    F.XB = (GAS bf16*)(ws + WS_XB); F.P = (GAS bf16*)(ws + WS_P); F.MID = (GAS bf16*)(ws + WS_MID); F.XC = (GAS bf16*)(ws + WS_XC); F.QKV = (GAS bf16*)(ws + WS_QKV); F.MIX = (GAS bf16*)(ws + WS_MIX); F.YS5 = (GAS bf16*)(ws + WS_YS5); } while (0)
    F.ctl = (gu32*)(ws + WS_CTL); F.in = args.in; F.out = (GAS float*)args.out; SET_WS();
    for (int u = threadIdx.x; u < (LDS_BYTES - LDSCTL_OFF) / 4; u += NWAVES * 64) ((LAS unsigned*)(F.lds + LDSCTL_OFF))[u] = 0u;
    __syncthreads();
    XcdBarrier bar; bar.bar = (unsigned*)(F.ctl + CW_BAR); bar.x = 0; bar.st = nullptr;
    const bool one_launch = (args.ph_hi - args.ph_lo) > 1;
    if (one_launch) bar = xcd_barrier_post((unsigned*)(F.ctl + CW_BAR), F.MISC + 8);
    if (F.vcu >= 128) (void)xcd_barrier_post((unsigned*)(F.ctl + CW_BAR) + XCD_BAR_WORDS, F.MISC + 10);

    int ph_lo = args.ph_lo, ph_hi = args.ph_hi;
    if (ph_lo == 0) { p0_prologue(F); ph_lo = 1; if (ph_lo < ph_hi) xcd_barrier(bar); }
    const bool do_final = (ph_hi == NPHASE); if (do_final) ph_hi = NPHASE - 1;
#ifndef REP_KIND
#define REP_KIND 0
#endif
#ifndef REV_DOWN
#define REV_DOWN 1
#endif
    int rep_mask = 0;
    for (int ph = ph_lo; ph < ph_hi; ++ph) {
        const int l = (ph - 1) / KPL, kidx = (ph - 1) % KPL, kind = kidx < 3 ? kidx + 1 : kidx + 2;
        SET_WS();
        PG8_LAS unsigned char* ring = F.lds + RING_OFF;
        if (kind == 1) {
            pg8::Gemm g{(const bf16*)F.XB, (const bf16*)(ws + WS_WIN + l * WIN_STRIDE), T, DIN, D, D, 0, 0}; pg8::StaticOrder S; S.init(T, DIN, F.G, (int)blockIdx.x); S.ss = ss_arr(F, l == 0 ? 0 : 2); S.rsl = (PG8_LAS float*)(F.lds + LDSCTL_OFF + 8192);
            pg8::EpiScaleBf16 E{F.P, DIN, S.rsl};
            pg8::gemm_phase<pg8::EpiScaleBf16, pg8::StaticOrder, true, true>(ring, g, S, E);
        } else if (kind == 2) { prep_phase(F, l); if (!(REP_KIND == 2 && ((rep_mask >> l) & 1))) hgrn_prep_phase(F, l); }
        else if (kind == 3) {
            for (int s = 0; s < 2; ++s) {
                pg8::Gemm g{s == 0 ? (const bf16*)F.XC : (const bf16*)(F.P + PC_MX), s == 0 ? (const bf16*)(ws + WS_WQK + l * WQK_STRIDE) : (const bf16*)(ws + WS_WV + l * WV_STRIDE), T, s == 0 ? 1024 : 512, 256, s == 0 ? 512 : DIN, 1, 256};
                pg8::StaticOrder S; S.init(T, g.N, F.G, (int)blockIdx.x);
                pg8::EpiScaleBf16 E{F.QKV + (s == 0 ? 0 : 1024), 1536, nullptr};
                pg8::gemm_phase<pg8::EpiScaleBf16, pg8::StaticOrder, true, true>(ring, g, S, E);
            }
        }
        else if (kind == 5) mixers_phase(F, l);
        else if (kind == 6) { post_phase(F, l, 0);
        } else if (kind == 7 || kind == 9) {
            pg8::Gemm g{kind == 7 ? (const bf16*)F.MIX : (const bf16*)F.MID, kind == 7 ? (const bf16*)(ws + WS_WOUT + l * WOUT_STRIDE) : (const bf16*)(ws + WS_WD + l * WD_STRIDE), T, D, kind == 7 ? D : DFF, kind == 7 ? D : DFF, 0, 0};
            pg8::StaticOrder S; S.init(T, D, F.G, (int)blockIdx.x); S.rev = (kind == 9) ? REV_DOWN : 0;
            pg8::EpiResid E{(kind == 7 && l == 0) ? (const GAS float*)F.in[0] : (const GAS float*)nullptr, F.XB, ss_arr(F, 2 * l + (kind == 7 ? 1 : 2))};
            pg8::gemm_phase<pg8::EpiResid, pg8::StaticOrder, true, true>(ring, g, S, E);
        } else if (kind == 8) {
            pg8::Gemm g{(const bf16*)F.XB, (const bf16*)(ws + WS_WGU + l * WGU_STRIDE), T, 2 * DFF, D, D, 0, 0}; pg8::StaticOrder S; S.init(T, 2 * DFF, F.G, (int)blockIdx.x); S.ss = ss_arr(F, 2 * l + 1); S.rsl = (PG8_LAS float*)(F.lds + LDSCTL_OFF + 8192);
            pg8::EpiSwiglu E{F.MID, DFF, S.rsl};
            pg8::gemm_phase<pg8::EpiSwiglu, pg8::StaticOrder, true, true>(ring, g, S, E);
        }
        if (ph + 1 < ph_hi || do_final) xcd_barrier(bar);
        if (REP_KIND != 0 && kind == REP_KIND && !(rep_mask & (1 << l))) { rep_mask |= 1 << l; --ph; }
    }
    if (do_final) { SET_WS(); final_phase(F); }
}

extern "C" void kernel_launch(void* const* d_in, const int* in_sizes, int n_in, void* d_out, int out_size, void* d_ws, size_t ws_size, hipStream_t stream) {
    static int grid = 0;
    if (grid == 0) {
        if (n_in != 29 || in_sizes[0] != T * D || out_size != T * D || ws_size < WS_END) { fprintf(stderr, "kernel_launch: unexpected shapes (n_in %d in0 %d out %d ws %zu)\n", n_in, n_in > 0 ? in_sizes[0] : -1, out_size, ws_size); grid = -1; return; }
        int dev = 0, cus = 0, per_cu = 0;
        if (hipGetDevice(&dev) != hipSuccess || hipDeviceGetAttribute(&cus, hipDeviceAttributeMultiprocessorCount, dev) != hipSuccess) { grid = -1; return; }
        if (hipFuncSetAttribute((const void*)fwd_kernel, hipFuncAttributeMaxDynamicSharedMemorySize, LDS_BYTES) != hipSuccess) { fprintf(stderr, "kernel_launch: hipFuncSetAttribute failed\n"); grid = -1; return; }
        if (hipOccupancyMaxActiveBlocksPerMultiprocessor(&per_cu, (const void*)fwd_kernel, NWAVES * 64, LDS_BYTES) != hipSuccess || per_cu < 1) fprintf(stderr, "kernel_launch: occupancy query reports %d\n", per_cu);
        (void)hipGetLastError();
        grid = cus;
    }
    if (grid < 0) return;
    if (hipMemsetAsync((char*)d_ws + WS_CTL, 0, CTL_ZERO_BYTES, stream) != hipSuccess) return;
    Args a{};
    for (int i = 0; i < 29; ++i) a.in[i] = (const float*)d_in[i];
    a.out = (float*)d_out; a.ws = (unsigned char*)d_ws;
#if MK_ONE_LAUNCH
    a.ph_lo = 0; a.ph_hi = NPHASE;
    hipLaunchKernelGGL(fwd_kernel, dim3(grid), dim3(NWAVES * 64), LDS_BYTES, stream, a);
#else
    for (int ph = 0; ph < NPHASE; ++ph) { a.ph_lo = ph; a.ph_hi = ph + 1; hipLaunchKernelGGL(fwd_kernel, dim3(grid), dim3(NWAVES * 64), LDS_BYTES, stream, a); }
#endif
}
```

```cpp
#include <hip/hip_runtime.h>
#include <cstdio>
#include <cstdint>
#define GAS __attribute__((address_space(1)))
namespace pg8 {
#define PG8_LAS __attribute__((address_space(3)))
typedef unsigned short bf16_t;
typedef short bf16x8 __attribute__((ext_vector_type(8)));
typedef float f32x4 __attribute__((ext_vector_type(4)));
typedef unsigned u32x4 __attribute__((ext_vector_type(4)));
constexpr int BM = 256, BK = 64, HALF = 128, HTB = HALF * BK * 2  , STAGE_BYTES = 8 * HTB, NXCD = 8, WGM = 8;

__host__ __device__ __forceinline__ int lds_byte(int r, int c) { const int st = (r >> 4) * 2 + (c >> 5), rr = r & 15, cc = c & 31, ob = rr * 64 + cc * 2; return st * 1024 + (ob ^ (((ob >> 9) & 1) << 5)); }
__host__ __device__ __forceinline__ void stage_rc(int b, int& R, int& C) { const int st = b / 1024, sb = b % 1024, swz = sb ^ (((sb >> 9) & 1) << 5); R = (st >> 1) * 16 + swz / 64; C = (st & 1) * 32 + (swz % 64) / 2; }
__host__ __device__ __forceinline__ int perm32(int rho) { const int n = rho >> 4, i = rho & 15; return 8 * (i >> 2) + 4 * n + (i & 3); }

struct Unit { int pm, pn; };
struct Gemm { const bf16_t* A; const bf16_t* Bt; int M, N, K, lda, amask, astep; };

struct StaticOrder {
    int nM, nN, nwg, G, c, rev;
    __host__ __device__ void init(int M, int N, int G_, int c_) { nM = M / BM; nN = N / BM; nwg = nM * nN; G = G_; c = c_; rev = 0; ss = nullptr; rsl = nullptr; }
    __host__ __device__ bool next(int i, Unit& u) const {
        const long L = (long)i * G + c; if (L >= nwg) return false;
        int wgid = rev ? nwg - 1 - (int)L : (int)L;
        const int nig = WGM * nN, gid = wgid / nig, fm = gid * WGM, gsz = (nM - fm) < WGM ? (nM - fm) : WGM;
        u.pm = fm + ((wgid % nig) % gsz); u.pn = (wgid % nig) / gsz; return true;
    }
    const GAS float* ss; PG8_LAS float* rsl;
    __device__ __forceinline__ void a_ready(const Unit& u, int ui) const {
        if (ss) { int t_ = threadIdx.x; asm volatile("" : "+v"(t_));
            if (t_ < 256) { const GAS float* p = ss + (size_t)(u.pm * BM + t_) * 16;
                const f32x4 a = *(const GAS f32x4*)p, b = *(const GAS f32x4*)(p + 4), c = *(const GAS f32x4*)(p + 8), d = *(const GAS f32x4*)(p + 12);
                const float s = (((a[0] + a[1]) + (a[2] + a[3])) + ((b[0] + b[1]) + (b[2] + b[3]))) + (((c[0] + c[1]) + (c[2] + c[3])) + ((d[0] + d[1]) + (d[2] + d[3])));
                rsl[(ui & 1) * 256 + t_] = __builtin_amdgcn_rsqf(s * (1.0f / 1024.0f) + 1e-6f); } }
    }
    __device__ __forceinline__ void done(const Unit&) const {}
};

typedef float f32x2 __attribute__((ext_vector_type(2)));
typedef __bf16 bf16x2v __attribute__((ext_vector_type(2)));
__device__ __forceinline__ unsigned cvt_pk_bf16(float lo, float hi) { f32x2 v = {lo, hi}; bf16x2v b = __builtin_convertvector(v, bf16x2v); return __builtin_bit_cast(unsigned, b); }
__device__ __forceinline__ float bf_lo(unsigned w) { return __builtin_bit_cast(float, w << 16); }
__device__ __forceinline__ float bf_hi(unsigned w) { return __builtin_bit_cast(float, w & 0xffff0000u); }
__device__ __forceinline__ float fast_sigmoid(float x) { return __builtin_amdgcn_rcpf(1.0f + __expf(-x)); }
constexpr float RMS_EPS = 1e-6f;
__device__ __forceinline__ float row_rs4(const GAS float* ss16, int row, int fq) {
    const f32x4 a = *(const GAS f32x4*)(ss16 + (size_t)row * 16 + 4 * fq);
    float s = (a[0] + a[1]) + (a[2] + a[3]);
    s += __shfl_xor(s, 16); s += __shfl_xor(s, 32);
    return __builtin_amdgcn_rsqf(s * (1.0f / 1024.0f) + RMS_EPS);
}
__device__ __forceinline__ float row_rs(const GAS float* ss16, int row) {
    const f32x4 a = *(const GAS f32x4*)(ss16 + (size_t)row * 16), b = *(const GAS f32x4*)(ss16 + (size_t)row * 16 + 4), c = *(const GAS f32x4*)(ss16 + (size_t)row * 16 + 8), d = *(const GAS f32x4*)(ss16 + (size_t)row * 16 + 12);
    const float s = (((a[0] + a[1]) + (a[2] + a[3])) + ((b[0] + b[1]) + (b[2] + b[3]))) + (((c[0] + c[1]) + (c[2] + c[3])) + ((d[0] + d[1]) + (d[2] + d[3])));
    return __builtin_amdgcn_rsqf(s * (1.0f / 1024.0f) + RMS_EPS);
}
#define EPI_LANES int t_ = threadIdx.x; asm volatile("" : "+v"(t_)); const int wid_ = __builtin_amdgcn_readfirstlane(t_ >> 6), wr = wid_ >> 2, wc = wid_ & 3, fr = t_ & 15, fq = (t_ & 63) >> 4, elane = t_ & 63; (void)elane;
struct EpiScaleBf16 {
    static constexpr bool PERM = true, AFTER_DRAIN = false;
    GAS bf16_t* O; int ldc; const PG8_LAS float* rsl;
    __device__ __forceinline__ void operator()(const f32x4 (&acc)[2][2][4][2], const Unit& u, int ui, int, int, int) const {
        EPI_LANES
        const int row0 = u.pm * BM + wr * 64 + fr, col0 = u.pn * BM + wc * 32 + 8 * fq;
#pragma unroll
        for (int ai = 0; ai < 2; ++ai)
#pragma unroll
            for (int m = 0; m < 4; ++m) { const int row = row0 + ai * HALF + m * 16; const float rs = rsl ? rsl[(ui & 1) * 256 + wr * 64 + ai * HALF + m * 16 + fr] : 1.0f;
                GAS bf16_t* rowp = O + (size_t)row * ldc + col0;
#pragma unroll
                for (int bj = 0; bj < 2; ++bj) { const f32x4 v0 = acc[ai][bj][m][0] * rs, v1 = acc[ai][bj][m][1] * rs;
                    u32x4 w; w.x = cvt_pk_bf16(v0[0], v0[1]); w.y = cvt_pk_bf16(v0[2], v0[3]); w.z = cvt_pk_bf16(v1[0], v1[1]); w.w = cvt_pk_bf16(v1[2], v1[3]);
                    *(GAS u32x4*)(rowp + bj * HALF) = w; } }
    }
};
struct EpiGlu {
    static constexpr bool PERM = true, AFTER_DRAIN = false;
    const GAS bf16_t* Y; GAS bf16_t* O; int ldc, ocol;
    __device__ __forceinline__ void operator()(const f32x4 (&acc)[2][2][4][2], const Unit& u, int ui, int, int, int) const {
        EPI_LANES
        const int row0 = u.pm * BM + wr * 64 + fr, col0 = u.pn * BM + wc * 32 + 8 * fq;
#pragma unroll
        for (int ai = 0; ai < 2; ++ai)
#pragma unroll
            for (int m = 0; m < 4; ++m) { const int row = row0 + ai * HALF + m * 16;
#pragma unroll
                for (int bj = 0; bj < 2; ++bj) { const u32x4 yv = *(const GAS u32x4*)(Y + (size_t)row * 256 + col0 + bj * HALF);
                    const f32x4 a0 = acc[ai][bj][m][0], a1 = acc[ai][bj][m][1];
                    u32x4 w;
                    w.x = cvt_pk_bf16(bf_lo(yv.x) * fast_sigmoid(a0[0]), bf_hi(yv.x) * fast_sigmoid(a0[1]));
                    w.y = cvt_pk_bf16(bf_lo(yv.y) * fast_sigmoid(a0[2]), bf_hi(yv.y) * fast_sigmoid(a0[3]));
                    w.z = cvt_pk_bf16(bf_lo(yv.z) * fast_sigmoid(a1[0]), bf_hi(yv.z) * fast_sigmoid(a1[1]));
                    w.w = cvt_pk_bf16(bf_lo(yv.w) * fast_sigmoid(a1[2]), bf_hi(yv.w) * fast_sigmoid(a1[3]));
                    *(GAS u32x4*)(O + (size_t)row * ldc + ocol + col0 + bj * HALF) = w; }
                asm volatile("" ::: "memory"); }
    }
};
struct EpiResid {
    static constexpr bool PERM = true, AFTER_DRAIN = false;
    const GAS float* x32; GAS bf16_t* xb; GAS float* ss;
    __device__ __forceinline__ void operator()(const f32x4 (&acc)[2][2][4][2], const Unit& u, int ui, int, int, int) const {
        EPI_LANES
        const int row0 = u.pm * BM + wr * 64 + fr, col0 = u.pn * BM + wc * 32 + 8 * fq;
#pragma unroll
        for (int ai = 0; ai < 2; ++ai)
#pragma unroll
            for (int m = 0; m < 4; ++m) { const int row = row0 + ai * HALF + m * 16; const size_t off = (size_t)row * 1024 + col0; float s = 0.f;
#pragma unroll
                for (int bj = 0; bj < 2; ++bj) { f32x4 r0, r1;
                    if (x32) { r0 = *(const GAS f32x4*)(x32 + off + bj * HALF); r1 = *(const GAS f32x4*)(x32 + off + bj * HALF + 4); }
                    else { const u32x4 rb = *(const GAS u32x4*)(xb + off + bj * HALF); r0 = (f32x4){bf_lo(rb.x), bf_hi(rb.x), bf_lo(rb.y), bf_hi(rb.y)}; r1 = (f32x4){bf_lo(rb.z), bf_hi(rb.z), bf_lo(rb.w), bf_hi(rb.w)}; }
                    const f32x4 v0 = r0 + acc[ai][bj][m][0], v1 = r1 + acc[ai][bj][m][1];
                    s += ((v0[0] * v0[0] + v0[1] * v0[1]) + (v0[2] * v0[2] + v0[3] * v0[3])) + ((v1[0] * v1[0] + v1[1] * v1[1]) + (v1[2] * v1[2] + v1[3] * v1[3]));
                    u32x4 w; w.x = cvt_pk_bf16(v0[0], v0[1]); w.y = cvt_pk_bf16(v0[2], v0[3]); w.z = cvt_pk_bf16(v1[0], v1[1]); w.w = cvt_pk_bf16(v1[2], v1[3]);
                    *(GAS u32x4*)(xb + off + bj * HALF) = w; }
                s += __builtin_bit_cast(float, __builtin_amdgcn_ds_bpermute((elane ^ 16) << 2, __builtin_bit_cast(int, s))); s += __builtin_bit_cast(float, __builtin_amdgcn_ds_bpermute((elane ^ 32) << 2, __builtin_bit_cast(int, s)));
                if (fq == 0) ss[(size_t)row * 16 + u.pn * 4 + wc] = s; }
    }
};
struct EpiSwiglu {
    static constexpr bool PERM = true, AFTER_DRAIN = false;
    GAS bf16_t* O; int ldc; const PG8_LAS float* rsl;
    __device__ __forceinline__ void operator()(const f32x4 (&acc)[2][2][4][2], const Unit& u, int ui, int, int, int) const {
        EPI_LANES
        const int row0 = u.pm * BM + wr * 64 + fr, col0 = u.pn * HALF + wc * 32 + 8 * fq;
#pragma unroll
        for (int ai = 0; ai < 2; ++ai)
#pragma unroll
            for (int m = 0; m < 4; ++m) { const int row = row0 + ai * HALF + m * 16; const float rs = rsl[(ui & 1) * 256 + wr * 64 + ai * HALF + m * 16 + fr], nrsl = rs * -1.4426950408889634f, rs2 = rs * rs; (void)row0;
                float o[8];
#pragma unroll
                for (int n = 0; n < 2; ++n)
#pragma unroll
                    for (int j = 0; j < 4; ++j) { const float g = acc[ai][0][m][n][j], up = acc[ai][1][m][n][j];
                        const float r = __builtin_amdgcn_rcpf(1.0f + __builtin_amdgcn_exp2f(g * nrsl)); o[n * 4 + j] = (g * up) * (r * rs2); }
                u32x4 w; w.x = cvt_pk_bf16(o[0], o[1]); w.y = cvt_pk_bf16(o[2], o[3]); w.z = cvt_pk_bf16(o[4], o[5]); w.w = cvt_pk_bf16(o[6], o[7]);
                *(GAS u32x4*)(O + (size_t)row * ldc + col0) = w; }
    }
};

template <class Epi, class Sched, bool ALIGN_EPI = false, bool SP2 = false>
__device__ __forceinline__ void gemm_phase(PG8_LAS unsigned char* lds, const Gemm g, const Sched& S, const Epi& E) {
    int tid_ = threadIdx.x; asm volatile("" : "+v"(tid_));
    const int tid = tid_, wid = __builtin_amdgcn_readfirstlane(tid >> 6), lane = tid & 63, wr = wid >> 2, wc = wid & 3, fr = lane & 15, fq = lane >> 4;
    const int K = g.K, nt = K / BK, lda = g.lda;
    unsigned voffA[2], voffB[2];
#pragma unroll
    for (int i = 0; i < 2; ++i) { int R, C; stage_rc(tid * 16 + i * 8192, R, C); const int Rb = Epi::PERM ? ((R & ~31) + perm32(R & 31)) : R;
        voffA[i] = (unsigned)(R * lda + C) * 2u; voffB[i] = (unsigned)(Rb * K + C) * 2u; }
    const size_t kstep = (size_t)(BK * 2);
    const size_t hstep = (size_t)HALF * K * 2;
    const size_t tstep = 2 * hstep; const size_t hstepA = (size_t)HALF * lda * 2, tstepA = 2 * hstepA;
    const unsigned ldsw = (unsigned)wid * 1024u;
    const int aoff = lds_byte(wr * 64 + fr, fq * 8), boff = lds_byte(wc * 32 + fr, fq * 8);
#define PG8_SA(b, h) (((b) * 2 + (h)) * HTB)
#define PG8_SB(b, h) ((4 + (b) * 2 + (h)) * HTB)
#define PG8_STAGE(bufoff, gbase, voff) do { _Pragma("unroll") for (int _i = 0; _i < 2; ++_i) \
        __builtin_amdgcn_global_load_lds((const unsigned*)((const char*)(gbase) + (voff)[_i]), (PG8_LAS unsigned*)(lds + (bufoff) + ldsw + _i * 8192), 16, 0, 0); } while (0)
#define PG8_LDA(dst, b, h) do { _Pragma("unroll") for (int m = 0; m < 4; ++m) _Pragma("unroll") for (int k = 0; k < 2; ++k) dst[m][k] = *(const PG8_LAS bf16x8*)(lds + PG8_SA(b, h) + aoff + m * 2048 + k * 1024); } while (0)
#define PG8_LDB(dst, b, h) do { _Pragma("unroll") for (int n = 0; n < 2; ++n) _Pragma("unroll") for (int k = 0; k < 2; ++k) dst[n][k] = *(const PG8_LAS bf16x8*)(lds + PG8_SB(b, h) + boff + n * 2048 + k * 1024); } while (0)
#define PG8_MMA(ai, bj, At, Bt) do { __builtin_amdgcn_s_setprio(1); _Pragma("unroll") for (int m = 0; m < 4; ++m) _Pragma("unroll") for (int n = 0; n < 2; ++n) _Pragma("unroll") for (int k = 0; k < 2; ++k) \
        acc[ai][bj][m][n] = __builtin_amdgcn_mfma_f32_16x16x32_bf16(Bt[n][k], At[m][k], acc[ai][bj][m][n], 0, 0, 0); __builtin_amdgcn_s_setprio(0); } while (0)
#define PG8_WAIT_V(n) asm volatile("s_waitcnt vmcnt(" #n ")" ::: "memory")
#define PG8_WAIT_L(n) asm volatile("s_waitcnt lgkmcnt(" #n ")" ::: "memory")
#define PG8_BAR __builtin_amdgcn_s_barrier()
#define PG8_SCHED __builtin_amdgcn_sched_barrier(0)
    Unit cur, nxt; int ui = 0;
    if (!S.next(0, cur)) return;
    f32x4 acc[2][2][4][2];
#pragma unroll
    for (int a = 0; a < 2; ++a)
#pragma unroll
        for (int b = 0; b < 2; ++b)
#pragma unroll
            for (int m = 0; m < 4; ++m)
#pragma unroll
                for (int n = 0; n < 2; ++n) acc[a][b][m][n] = (f32x4){0.f, 0.f, 0.f, 0.f};
    bf16x8 At[4][2], B0[2][2], B1[2][2];
    const char* cA = (const char*)g.A + (size_t)cur.pm * tstepA + (size_t)((cur.pn & g.amask) * g.astep) * 2; const char* cB = (const char*)g.Bt + (size_t)cur.pn * tstep;
    S.a_ready(cur, 0);
    if constexpr (SP2) {
        PG8_STAGE(PG8_SB(0, 0), cB, voffB); PG8_STAGE(PG8_SB(0, 1), cB + hstep, voffB); PG8_STAGE(PG8_SA(0, 0), cA, voffA); PG8_STAGE(PG8_SA(0, 1), cA + hstepA, voffA);
        if (wr == 1) PG8_BAR;
        PG8_WAIT_V(2); PG8_BAR;
        PG8_STAGE(PG8_SB(1, 0), cB + kstep, voffB); PG8_STAGE(PG8_SA(1, 0), cA + kstep, voffA); PG8_STAGE(PG8_SB(1, 1), cB + hstep + kstep, voffB);
        PG8_WAIT_V(6); PG8_BAR;
    } else {
        PG8_STAGE(PG8_SB(0, 0), cB, voffB); PG8_STAGE(PG8_SA(0, 0), cA, voffA); PG8_STAGE(PG8_SB(0, 1), cB + hstep, voffB); PG8_STAGE(PG8_SA(0, 1), cA + hstepA, voffA);
        if (wr == 1) PG8_BAR;
        PG8_WAIT_V(4); PG8_BAR;
        PG8_STAGE(PG8_SB(1, 0), cB + kstep, voffB); PG8_STAGE(PG8_SA(1, 0), cA + kstep, voffA); PG8_STAGE(PG8_SB(1, 1), cB + hstep + kstep, voffB);
        PG8_WAIT_V(6); PG8_BAR;
    }
    for (;;) {
        const bool has_next = S.next(ui + 1, nxt);
        const char* nA = has_next ? (const char*)g.A + (size_t)nxt.pm * tstepA + (size_t)((nxt.pn & g.amask) * g.astep) * 2 : cA; const char* nB = has_next ? (const char*)g.Bt + (size_t)nxt.pn * tstep : cB;
        for (int t = 0; t < nt; t += 2) {
            const bool last = (t == nt - 2);
            const char* a1 = cA + (size_t)(t + 1) * kstep;
            const char* a2 = last ? nA : cA + (size_t)(t + 2) * kstep; const char* b2 = last ? nB : cB + (size_t)(t + 2) * kstep;
            const char* a3 = a2 + kstep; const char* b3 = b2 + kstep;
            if (last && has_next) S.a_ready(nxt, ui + 1);
            if constexpr (SP2) {
            PG8_LDB(B0, 0, 0); PG8_LDB(B1, 0, 1); PG8_SCHED; PG8_LDA(At, 0, 0); PG8_STAGE(PG8_SA(1, 1), a1 + hstepA, voffA);
            PG8_WAIT_V(8); PG8_WAIT_L(0); PG8_BAR; PG8_MMA(0, 0, At, B0); PG8_MMA(0, 1, At, B1); PG8_BAR; PG8_SCHED;
            PG8_LDA(At, 0, 1); PG8_STAGE(PG8_SB(0, 0), b2, voffB); PG8_STAGE(PG8_SB(0, 1), b2 + hstep, voffB); PG8_STAGE(PG8_SA(0, 0), a2, voffA);
            PG8_WAIT_V(8); PG8_WAIT_L(0); PG8_BAR; PG8_MMA(1, 0, At, B0); PG8_MMA(1, 1, At, B1); PG8_BAR; PG8_SCHED;
            PG8_LDB(B0, 1, 0); PG8_LDB(B1, 1, 1); PG8_SCHED; PG8_LDA(At, 1, 0); PG8_STAGE(PG8_SA(0, 1), a2 + hstepA, voffA);
            PG8_WAIT_V(8); PG8_WAIT_L(0); PG8_BAR; PG8_MMA(0, 0, At, B0); PG8_MMA(0, 1, At, B1); PG8_BAR; PG8_SCHED;
            PG8_LDA(At, 1, 1); PG8_STAGE(PG8_SB(1, 0), b3, voffB); PG8_STAGE(PG8_SB(1, 1), b3 + hstep, voffB); PG8_STAGE(PG8_SA(1, 0), a3, voffA);
            PG8_WAIT_V(8); PG8_WAIT_L(0); PG8_BAR; PG8_MMA(1, 0, At, B0); PG8_MMA(1, 1, At, B1); PG8_BAR; PG8_SCHED;
            } else {
            PG8_LDB(B0, 0, 0); PG8_SCHED; PG8_LDA(At, 0, 0); PG8_STAGE(PG8_SA(1, 1), a1 + hstepA, voffA);
            PG8_WAIT_L(8); PG8_BAR; PG8_WAIT_L(0); PG8_MMA(0, 0, At, B0); PG8_BAR; PG8_SCHED;
            PG8_LDB(B1, 0, 1); PG8_STAGE(PG8_SB(0, 0), b2, voffB);
            PG8_BAR; PG8_WAIT_L(0); PG8_MMA(0, 1, At, B1); PG8_BAR;
            PG8_LDA(At, 0, 1); PG8_STAGE(PG8_SA(0, 0), a2, voffA);
            PG8_BAR; PG8_WAIT_L(0); PG8_MMA(1, 0, At, B0); PG8_BAR; PG8_SCHED;
            PG8_STAGE(PG8_SB(0, 1), b2 + hstep, voffB);
            PG8_WAIT_V(6); PG8_BAR; PG8_MMA(1, 1, At, B1); PG8_BAR;
            PG8_LDB(B0, 1, 0); PG8_SCHED; PG8_LDA(At, 1, 0); PG8_STAGE(PG8_SA(0, 1), a2 + hstepA, voffA);
            PG8_WAIT_L(8); PG8_BAR; PG8_WAIT_L(0); PG8_MMA(0, 0, At, B0); PG8_BAR; PG8_SCHED;
            PG8_LDB(B1, 1, 1); PG8_STAGE(PG8_SB(1, 0), b3, voffB);
            PG8_BAR; PG8_WAIT_L(0); PG8_MMA(0, 1, At, B1); PG8_BAR;
            PG8_LDA(At, 1, 1); PG8_STAGE(PG8_SA(1, 0), a3, voffA);
            PG8_BAR; PG8_WAIT_L(0); PG8_MMA(1, 0, At, B0); PG8_BAR; PG8_SCHED;
            PG8_STAGE(PG8_SB(1, 1), b3 + hstep, voffB);
            PG8_WAIT_V(6); PG8_BAR; PG8_MMA(1, 1, At, B1); PG8_BAR;
            }
        }
        if constexpr (ALIGN_EPI) { if (wr == 0) PG8_BAR; }
        if constexpr (!Epi::AFTER_DRAIN) { E(acc, cur, ui, wc, fr, fq); S.done(cur); }
        if (!has_next) break;
#pragma unroll
        for (int a = 0; a < 2; ++a)
#pragma unroll
            for (int b = 0; b < 2; ++b)
#pragma unroll
                for (int m = 0; m < 4; ++m)
#pragma unroll
                    for (int n = 0; n < 2; ++n) acc[a][b][m][n] = (f32x4){0.f, 0.f, 0.f, 0.f};
        cur = nxt; cA = nA; cB = nB; ++ui;
        if constexpr (ALIGN_EPI) { if (wr == 1) PG8_BAR; }
    }
    PG8_WAIT_V(0);
    if constexpr (!ALIGN_EPI) { if (wr == 0) PG8_BAR; }
    PG8_BAR;
    if constexpr (Epi::AFTER_DRAIN) { E.fused(acc, cur, wr, wc, fr, fq, lds, wid, lane); S.done(cur); }
#undef PG8_SA
#undef PG8_SB
#undef PG8_STAGE
#undef PG8_LDA
#undef PG8_LDB
#undef PG8_MMA
#undef PG8_WAIT_V
#undef PG8_WAIT_L
#undef PG8_BAR
#undef PG8_SCHED
}
}
constexpr int NB = 16, SEQ = 2048, D = 1024, T = NB * SEQ, DIN = 2304, DFF = 2816, DEPTH = 2;
constexpr int NWAVES = 8;
constexpr int PC_Q = 0, PC_F = 256, PC_I = 512, PC_G = 768, PC_U = 1024, PC_MX = 1280, PC_MZ = 1792;
constexpr float EPS = 1e-6f;
constexpr int NPHASE = 18, KPL = 8;
#ifndef MK_ONE_LAUNCH
#define MK_ONE_LAUNCH 1
#endif

constexpr size_t MiB = 1u << 20;
constexpr size_t WS_CTL = 0, CTL_ZERO_BYTES = 1 * MiB;
constexpr size_t WS_PAR = 1 * MiB;
constexpr size_t WS_SS0 = 2 * MiB;
constexpr size_t WS_GATES = 3 * MiB;
constexpr size_t WS_WIN = 4 * MiB, WIN_STRIDE = 6 * MiB;
constexpr size_t WS_WOUT = 16 * MiB, WOUT_STRIDE = 2 * MiB;
constexpr size_t WS_WGU = 20 * MiB, WGU_STRIDE = 11 * MiB;
constexpr size_t WS_WD = 42 * MiB, WD_STRIDE = 6 * MiB;
constexpr size_t WS_WQK = 54 * MiB, WQK_STRIDE = 1 * MiB;
constexpr size_t WS_WV = 56 * MiB, WV_STRIDE = MiB / 2;
constexpr size_t WS_WGLU = 57 * MiB, WGLU_STRIDE = MiB / 8;
constexpr size_t WS_HDEC = 58 * MiB;
constexpr size_t WS_XB = 64 * MiB;
constexpr size_t WS_P = 128 * MiB;
constexpr size_t WS_MID = 128 * MiB;
constexpr size_t WS_XC = 272 * MiB;
constexpr size_t WS_QKV = 304 * MiB;
constexpr size_t WS_MIX = 400 * MiB;
constexpr size_t WS_YS5 = 464 * MiB;
constexpr size_t WS_SS = 480 * MiB;
constexpr size_t WS_END = 490 * MiB;
static_assert(WS_MID + (size_t)T * DFF * 2 <= WS_QKV && WS_P + (size_t)T * DIN * 2 <= WS_XC, "d_ws map");
constexpr int CW_TMO = 0, CW_CODE = 1, CW_BAR = 4096;
constexpr size_t CTL_SS_OFF = 256 * 1024;
constexpr int PAR_LBV = 0, PAR_S5A = 1024, PAR_S5BB = 8192, PAR_G1 = 73728, PAR_G2 = 81920;

constexpr int RING_OFF = 0, RING_BYTES = 131072;
constexpr int LDSCTL_OFF = RING_BYTES, MISC_OFF = LDSCTL_OFF + 320;
constexpr int LDS_BYTES = 147456;

#define LAS __attribute__((address_space(3)))
typedef unsigned short bf16;
typedef unsigned v4u __attribute__((ext_vector_type(4)));
typedef float f32x4 __attribute__((ext_vector_type(4)));
typedef short bf16x8 __attribute__((ext_vector_type(8)));
typedef GAS unsigned gu32;
typedef GAS unsigned long long gu64;
#define RLX_AGENT __ATOMIC_RELAXED, __HIP_MEMORY_SCOPE_AGENT
#define LDS_WAIT() asm volatile("s_waitcnt lgkmcnt(0)" ::: "memory")
#define VM_WAIT() asm volatile("s_waitcnt vmcnt(0)" ::: "memory")
__device__ __forceinline__ unsigned long long rt() { return __builtin_amdgcn_s_memrealtime(); }
__device__ __forceinline__ unsigned f2bf(float f) { unsigned u = __builtin_bit_cast(unsigned, f); return (u + 0x7fffu + ((u >> 16) & 1u)) >> 16; }
__device__ __forceinline__ unsigned pk2(float lo, float hi) { return f2bf(lo) | (f2bf(hi) << 16); }
#define XB_TMO      128
#define XB_XCNT(j)  (256  + 64 * (j))
#define XB_XSUB(j)  (1280 + 64 * (j))
#define XB_XGEN(j)  (2304 + 64 * (j))
#define XB_TOP      3328
#define XB_TOPGEN   3392
#define XCD_BAR_WORDS 3456
#define XB_SPIN_CAP (1u << 18)

__device__ __forceinline__ unsigned xb_ld(unsigned* p)              { return __hip_atomic_load(p, __ATOMIC_RELAXED, __HIP_MEMORY_SCOPE_AGENT); }
__device__ __forceinline__ unsigned xb_add(unsigned* p, unsigned v) { return __hip_atomic_fetch_add(p, v, __ATOMIC_RELAXED, __HIP_MEMORY_SCOPE_AGENT); }
__device__ __forceinline__ unsigned xb_xcc_id() { return (unsigned)__builtin_amdgcn_s_getreg((3 << 11) | 20) & 0xFu; }
#define XB_SPIN(cond, bar) do { unsigned _sp = 0; while (cond) { __builtin_amdgcn_s_sleep(1); \
    if ((++_sp & 255u) == 0u) { if (xb_ld(&(bar)[XB_TMO])) break; if (_sp > XB_SPIN_CAP) { atomicAdd(&(bar)[XB_TMO], 1u); break; } } } } while (0)

struct XcdBarrier {
    unsigned* bar; unsigned x;
    unsigned gexp;
    volatile LAS unsigned* st;
};

__device__ __forceinline__ XcdBarrier xcd_barrier_post(unsigned* bar, volatile LAS unsigned* st) {
    XcdBarrier b; b.bar = bar; b.x = xb_xcc_id(); b.st = st; b.gexp = 0u;
    if (threadIdx.x == 0) (void)xb_add(&bar[XB_XCNT(b.x)], 1u);
    return b;
}
__device__ __forceinline__ void xcd_barrier_complete(unsigned* bar, unsigned x, unsigned& nloc, unsigned& nx, unsigned gexp) {
    const unsigned G = gexp ? gexp : gridDim.x * gridDim.y * gridDim.z;
    unsigned sum, cnt, mine, sp = 0u;
    for (;;) {
        sum = 0u; cnt = 0u; mine = 0u;
#pragma unroll
        for (unsigned j = 0; j < 16; ++j) { const unsigned c = xb_ld(&bar[XB_XCNT(j)]); sum += c; cnt += (c > 0u) ? 1u : 0u; mine = (j == x) ? c : mine; }
        if (sum == G) break;
        __builtin_amdgcn_s_sleep(1);
        if ((++sp & 255u) == 0u) { if (xb_ld(&bar[XB_TMO])) break; if (sp > XB_SPIN_CAP) { atomicAdd(&bar[XB_TMO], 1u); break; } }
    }
    nloc = mine > 0u ? mine : 1u; nx = cnt > 0u ? cnt : 1u;
}

__device__ __forceinline__ void xcd_barrier(const XcdBarrier& b) {
    asm volatile("s_waitcnt vmcnt(0)" ::: "memory");
    __syncthreads();
    if (threadIdx.x == 0) {
        unsigned* bar = b.bar;
        __builtin_amdgcn_s_waitcnt(0);
        unsigned nloc = b.st[0], nx = b.st[1];
        if (nloc == 0u) { xcd_barrier_complete(bar, b.x, nloc, nx, b.gexp); b.st[0] = nloc; b.st[1] = nx; }
        const unsigned old = xb_add(&bar[XB_XSUB(b.x)], 1u);
        const unsigned gen = old / nloc;
        if (old + 1u == (gen + 1u) * nloc) {
            __builtin_amdgcn_fence(__ATOMIC_RELEASE, "agent");
            asm volatile("s_waitcnt vmcnt(0)" ::: "memory");
            const unsigned og = xb_add(&bar[XB_TOP], 1u);
            const unsigned tg = og / nx;
            if (og + 1u == (tg + 1u) * nx) xb_add(&bar[XB_TOPGEN], 1u);
            else XB_SPIN(xb_ld(&bar[XB_TOPGEN]) == tg, bar);
            __builtin_amdgcn_fence(__ATOMIC_ACQUIRE, "agent");
            xb_add(&bar[XB_XGEN(b.x)], 1u);
            asm volatile("s_waitcnt vmcnt(0)" ::: "memory");
        } else {
            XB_SPIN(xb_ld(&bar[XB_XGEN(b.x)]) == gen, bar);
            __builtin_amdgcn_fence(__ATOMIC_ACQUIRE, "agent");
            asm volatile("s_waitcnt vmcnt(0)" ::: "memory");
        }
    }
    __syncthreads();
}
typedef unsigned u32x2 __attribute__((ext_vector_type(2)));
struct Frame {
    LAS unsigned char* lds;
    volatile LAS unsigned* MISC;
    gu32* ctl;
    int vcu, G;
    const float* const* in;
    GAS float* out;
    GAS unsigned char* ws;
    GAS float* par; GAS float* ss0; GAS float* gates;
    GAS bf16 *XB, *P, *MID, *XC, *QKV, *MIX, *YS5;
};
__device__ __forceinline__ GAS float* ss_arr(Frame& F, int i) { return (GAS float*)(F.ws + WS_SS) + (size_t)i * T * 16; }
__device__ __forceinline__ float bf2f(bf16 v) { return __builtin_bit_cast(float, (unsigned)v << 16); }
__device__ __forceinline__ float sigmoidf_(float x) { return 1.0f / (1.0f + __expf(-x)); }
typedef float f32x2_t __attribute__((ext_vector_type(2))); typedef __bf16 bf16x2_t __attribute__((ext_vector_type(2)));
__device__ __forceinline__ unsigned cvtpk(float lo, float hi) { f32x2_t v = {lo, hi}; bf16x2_t b = __builtin_convertvector(v, bf16x2_t); return __builtin_bit_cast(unsigned, b); }
__device__ __forceinline__ float frcp(float x) { return __builtin_amdgcn_rcpf(x); }
__device__ __forceinline__ float frsq(float x) { return __builtin_amdgcn_rsqf(x); }
__device__ __forceinline__ float fsigmoid(float x) { return __builtin_amdgcn_rcpf(1.0f + __expf(-x)); }
__device__ __forceinline__ float wave_sum_l(float v, int lane) {
#pragma unroll
    for (int o = 1; o < 64; o <<= 1) v += __builtin_bit_cast(float, __builtin_amdgcn_ds_bpermute((lane ^ o) << 2, __builtin_bit_cast(int, v)));
    return v;
}
#define LANE_SETUP int tid_ = threadIdx.x; asm volatile("" : "+v"(tid_)); const int tid = tid_, lane = tid & 63, wave = __builtin_amdgcn_readfirstlane(tid >> 6); (void)tid; (void)lane; (void)wave;
#define SHX(v, k) __builtin_bit_cast(float, __builtin_amdgcn_ds_bpermute(((lane) ^ (k)) << 2, __builtin_bit_cast(int, (float)(v))))
#define SHUP(v, o) __builtin_bit_cast(float, __builtin_amdgcn_ds_bpermute((((lane) >= (o)) ? (lane) - (o) : (lane)) << 2, __builtin_bit_cast(int, (float)(v))))
#define WSUM(v) wave_sum_l((v), lane)
__device__ __forceinline__ float gelu_tanh(float y) {
    const float z = 0.7978845608028654f * (y + 0.044715f * y * y * y);
    const float t = 1.0f - 2.0f * __builtin_amdgcn_rcpf(1.0f + __expf(2.0f * z));
    return 0.5f * y * (1.0f + t);
}

__device__ __forceinline__ void p0_transpose_item(const float* W, int K, int N, const float* ksc, bf16* WT, int dst_row0, LAS float* scr, int kb, int nb, int lane) {
    const int k0 = 64 * kb, n0 = 32 * nb;
    float tv[32];
#pragma unroll
    for (int i = 0; i < 32; ++i) { const int kk = 2 * i + (lane >> 5); tv[i] = W[(size_t)(k0 + kk) * N + n0 + (lane & 31)]; }
#pragma unroll
    for (int i = 0; i < 32; ++i) { const int kk = 2 * i + (lane >> 5); float v = tv[i]; if (ksc) v *= ksc[k0 + kk]; scr[kk * 33 + (lane & 31)] = v; }
    LDS_WAIT(); asm volatile("" ::: "memory");
    const int c = lane & 7;
#pragma unroll
    for (int j = 0; j < 4; ++j) { const int n = (lane >> 3) + 8 * j; const LAS float* s = scr + (8 * c) * 33 + n;
        v4u o; o.x = pk2(s[0 * 33], s[1 * 33]); o.y = pk2(s[2 * 33], s[3 * 33]); o.z = pk2(s[4 * 33], s[5 * 33]); o.w = pk2(s[6 * 33], s[7 * 33]);
        *(GAS v4u*)(WT + (size_t)(dst_row0 + n) * K + k0 + 8 * c) = o; }
    LDS_WAIT(); asm volatile("" ::: "memory");
}
__device__ __forceinline__ void weight_items(Frame& F, LAS float* scr, int first, int stride, int lo, int hi, int lane) {
    constexpr int I_IN = 16 * 72, I_OUT = 16 * 32, I_G = 16 * 88, I_U = I_G, I_D = 44 * 32, I_GLU = 4 * 8, I_LAYER = I_IN + I_OUT + I_G + I_U + I_D + I_GLU;
    for (int it = lo + first; it < hi; it += stride) {
        const int l = it / I_LAYER; int r = it % I_LAYER;
        if (r < I_IN) { const int kb = r / 72, nb = r % 72; p0_transpose_item(F.in[2] + (size_t)l * D * DIN, D, DIN, F.in[1] + l * D, (bf16*)(F.ws + WS_WIN + l * WIN_STRIDE), 32 * nb, scr, kb, nb, lane); continue; } r -= I_IN;
        if (r < I_OUT) { const int kb = r / 32, nb = r % 32; p0_transpose_item(F.in[23] + (size_t)l * D * D, D, D, nullptr, (bf16*)(F.ws + WS_WOUT + l * WOUT_STRIDE), 32 * nb, scr, kb, nb, lane); continue; } r -= I_OUT;
        if (r < I_G) { const int kb = r / 88, nb = r % 88, n0 = 32 * nb; p0_transpose_item(F.in[25] + (size_t)l * D * DFF, D, DFF, F.in[24] + l * D, (bf16*)(F.ws + WS_WGU + l * WGU_STRIDE), 256 * (n0 / 128) + (n0 % 128), scr, kb, nb, lane); continue; } r -= I_G;
        if (r < I_U) { const int kb = r / 88, nb = r % 88, n0 = 32 * nb; p0_transpose_item(F.in[26] + (size_t)l * D * DFF, D, DFF, F.in[24] + l * D, (bf16*)(F.ws + WS_WGU + l * WGU_STRIDE), 256 * (n0 / 128) + 128 + (n0 % 128), scr, kb, nb, lane); continue; } r -= I_U;
        if (r < I_D) { const int kb = r / 32, nb = r % 32; p0_transpose_item(F.in[27] + (size_t)l * DFF * D, DFF, D, nullptr, (bf16*)(F.ws + WS_WD + l * WD_STRIDE), 32 * nb, scr, kb, nb, lane); continue; } r -= I_D;
        { const int kb = r / 8, nb = r % 8; p0_transpose_item(F.in[13] + (size_t)l * 256 * 256, 256, 256, nullptr, (bf16*)(F.ws + WS_WGLU + l * WGLU_STRIDE), 32 * nb, scr, kb, nb, lane); }
    }
}
constexpr int W_ITEMS_EARLY = 16 * 72, W_ITEMS_ALL = 2 * (16 * 72 + 16 * 32 + 2 * 16 * 88 + 44 * 32 + 4 * 8), W_ITEMS_SPLIT = W_ITEMS_ALL - 2560;
__device__ __forceinline__ void p0_prologue(Frame& F) {
    LANE_SETUP
    LAS float* scr = (LAS float*)(F.lds + RING_OFF + wave * 16384);
    const int gw = F.vcu * NWAVES + wave, NGW = F.G * NWAVES;
    weight_items(F, scr, gw, NGW, 0, W_ITEMS_EARLY, lane);
    {
        const int gt = (F.vcu * NWAVES + wave) * 64 + lane, NGT = F.G * NWAVES * 64;
        constexpr int PER_L = (1024 * 256 + 512 * 256) / 8;
        for (int it = gt; it < DEPTH * PER_L; it += NGT) {
            const int l = it / PER_L; int r = it % PER_L; const float* src; bf16* dst; float sc = 1.f; int n, k0;
            if (r < 1024 * 256 / 8) { n = r / 32; k0 = (r % 32) * 8; dst = (bf16*)(F.ws + WS_WQK + l * WQK_STRIDE) + (size_t)n * 256 + k0;
                if (n < 512) src = F.in[16]; else { src = F.in[17]; sc = 0.08838834764831845f; } }
            else { r -= 1024 * 256 / 8; n = r / 32; k0 = (r % 32) * 8; dst = (bf16*)(F.ws + WS_WV + l * WV_STRIDE) + (size_t)n * 256 + k0; src = F.in[18]; }
            const int hh = (n & 511) >> 7, e = n & 127;
            v4u o = (v4u){0u, 0u, 0u, 0u};
            if ((k0 >> 7) == (hh & 1)) { const float* s = src + ((size_t)(l * 4 + hh) * 128 + (k0 & 127)) * 128 + e;
                o.x = pk2(s[0] * sc, s[128] * sc); o.y = pk2(s[256] * sc, s[384] * sc); o.z = pk2(s[512] * sc, s[640] * sc); o.w = pk2(s[768] * sc, s[896] * sc); }
            *(GAS v4u*)dst = o;
        }
        if (gt < 512) { const int c = gt & 255; const float r0 = F.in[3][c], r1 = F.in[3][256 + c], mx = fmaxf(r0, r1), e0 = expf(r0 - mx), e1 = expf(r1 - mx);
            F.par[PAR_LBV + gt] = (gt < 256) ? 0.f : e1 / (e0 + e1); }
        for (int it = F.vcu * NWAVES + wave; it < 2 * DEPTH * 512; it += F.G * NWAVES) {
            const int which = it >> 10, l = (it >> 9) & 1, k = it & 511, hh = k >> 7, d = k & 127;
            const float* wg = F.in[19] + (size_t)l * 1536 * 8; float acc[8];
#pragma unroll
            for (int j = 0; j < 8; ++j) acc[j] = 0.f;
#pragma unroll
            for (int half = 0; half < 2; ++half) { const int e = lane + 64 * half; const size_t wo = ((size_t)(l * 4 + hh) * 128 + d) * 128 + e;
                if (which == 0) { const float q = F.in[16][wo], kk = F.in[17][wo] * 0.08838834764831845f;
                    const f32x4 a0 = *(const GAS f32x4*)(wg + (size_t)(hh * 128 + e) * 8), a1 = *(const GAS f32x4*)(wg + (size_t)(hh * 128 + e) * 8 + 4);
                    const f32x4 b0 = *(const GAS f32x4*)(wg + (size_t)(512 + hh * 128 + e) * 8), b1 = *(const GAS f32x4*)(wg + (size_t)(512 + hh * 128 + e) * 8 + 4);
#pragma unroll
                    for (int j = 0; j < 4; ++j) { acc[j] += q * a0[j] + kk * b0[j]; acc[4 + j] += q * a1[j] + kk * b1[j]; } }
                else { const float v = F.in[18][wo];
                    const f32x4 a0 = *(const GAS f32x4*)(wg + (size_t)(1024 + hh * 128 + e) * 8), a1 = *(const GAS f32x4*)(wg + (size_t)(1024 + hh * 128 + e) * 8 + 4);
#pragma unroll
                    for (int j = 0; j < 4; ++j) { acc[j] += v * a0[j]; acc[4 + j] += v * a1[j]; } } }
#pragma unroll
            for (int j = 0; j < 8; ++j) acc[j] = WSUM(acc[j]);
            if (lane < 8) { float v = acc[0];
#pragma unroll
                for (int j = 1; j < 8; ++j) v = (lane == j) ? acc[j] : v;
                F.par[(which == 0 ? PAR_G1 : PAR_G2) + (l * 512 + k) * 8 + lane] = v; }
        }
        if (gt < DEPTH * 16 * 64) { const int l = gt >> 10, g = (gt >> 6) & 15, p = gt & 63;
            const float lre = F.in[5][gt], lim = F.in[6][gt], dt = expf(F.in[7][l * 16 + g]);
            const float mag = expf(lre * dt), ang = lim * dt; const float ar = mag * cosf(ang), ai = mag * sinf(ang);
            const float den = lre * lre + lim * lim, nr = ar - 1.0f, ni = ai; const float cr = (nr * lre + ni * lim) / den, ci = (ni * lre - nr * lim) / den;
            F.par[PAR_S5A + gt * 2] = ar; F.par[PAR_S5A + gt * 2 + 1] = ai;
            for (int h = 0; h < 16; ++h) { const float br = F.in[8][(size_t)gt * 16 + h], bi = F.in[9][(size_t)gt * 16 + h];
                F.par[PAR_S5BB + gt * 32 + h] = cr * br - ci * bi; F.par[PAR_S5BB + gt * 32 + 16 + h] = cr * bi + ci * br; }
            (void)p; }
    }
    for (int m4 = gw; m4 < T / 4; m4 += NGW) {
        f32x4 v[4][4];
#pragma unroll
        for (int q = 0; q < 4; ++q) { const GAS f32x4* xr = (const GAS f32x4*)(F.in[0] + (size_t)(4 * m4 + q) * D) + lane;
#pragma unroll
            for (int j = 0; j < 4; ++j) v[q][j] = xr[64 * j]; }
#pragma unroll
        for (int q = 0; q < 4; ++q) { GAS unsigned long long* o8 = (GAS unsigned long long*)(F.XB + (size_t)(4 * m4 + q) * D) + lane; float s = 0.f;
#pragma unroll
            for (int j = 0; j < 4; ++j) { const f32x4 x = v[q][j]; s += (x.x * x.x + x.y * x.y) + (x.z * x.z + x.w * x.w);
                o8[64 * j] = (unsigned long long)pk2(x.x, x.y) | ((unsigned long long)pk2(x.z, x.w) << 32); }
            s = WSUM(s); if (lane < 16) F.ss0[(size_t)(4 * m4 + q) * 16 + lane] = lane == 0 ? s : 0.f; }
    }
}

__device__ __forceinline__ void prep_phase(Frame& F, int l) {
    LANE_SETUP
    const int gw = F.vcu * NWAVES + wave, NGW = F.G * NWAVES, c0 = lane * 8;
    const float* cw = F.in[14] + (size_t)l * 4 * 512; const float* cb = F.in[15] + l * 512;
    float g1[8][8], g2[8][8];
#pragma unroll
    for (int j = 0; j < 8; ++j)
#pragma unroll
        for (int q = 0; q < 2; ++q) { const f32x4 a1 = *(const GAS f32x4*)(F.par + PAR_G1 + (l * 512 + c0 + j) * 8 + 4 * q), a2 = *(const GAS f32x4*)(F.par + PAR_G2 + (l * 512 + c0 + j) * 8 + 4 * q);
            g1[j][4 * q] = a1.x; g1[j][4 * q + 1] = a1.y; g1[j][4 * q + 2] = a1.z; g1[j][4 * q + 3] = a1.w; g2[j][4 * q] = a2.x; g2[j][4 * q + 1] = a2.y; g2[j][4 * q + 2] = a2.z; g2[j][4 * q + 3] = a2.w; }
    const int gq = 4 * (lane >> 5) + 2 * ((lane >> 4) & 1) + ((lane >> 3) & 1); const float bgl = F.in[20][l * 8 + gq];
    float cwr[4][8], cbr[8];
#pragma unroll
    for (int j = 0; j < 8; ++j) { cbr[j] = cb[c0 + j];
#pragma unroll
        for (int k = 0; k < 4; ++k) cwr[k][j] = cw[k * 512 + c0 + j]; }
    constexpr int RUN = 8;
    for (int it = gw; it < T / RUN; it += NGW) {
        const int m0 = it * RUN, s0 = m0 & (SEQ - 1);
        v4u rw[RUN + 3];
#pragma unroll
        for (int i = 0; i < RUN + 3; ++i) { rw[i] = (v4u){0u, 0u, 0u, 0u}; if (s0 - 3 + i >= 0) rw[i] = *(const GAS v4u*)(F.P + (size_t)(m0 - 3 + i) * DIN + PC_MX + c0); }
#pragma unroll
        for (int t = 0; t < RUN; ++t) {
            const int m = m0 + t; float a[8], xm[8];
#pragma unroll
            for (int j = 0; j < 8; ++j) a[j] = cbr[j];
#pragma unroll
            for (int k = 0; k < 4; ++k) { const v4u w = rw[t + k];
                const float x[8] = {pg8::bf_lo(w.x), pg8::bf_hi(w.x), pg8::bf_lo(w.y), pg8::bf_hi(w.y), pg8::bf_lo(w.z), pg8::bf_hi(w.z), pg8::bf_lo(w.w), pg8::bf_hi(w.w)};
#pragma unroll
                for (int j = 0; j < 8; ++j) { a[j] += cwr[k][j] * x[j]; if (k == 3) xm[j] = x[j]; } }
#pragma unroll
            for (int j = 0; j < 8; ++j) a[j] = a[j] * fsigmoid(a[j]);
            { float ga[8];
#pragma unroll
              for (int q = 0; q < 8; ++q) { float v = 0.f;
#pragma unroll
                  for (int j = 0; j < 8; ++j) v += a[j] * g1[j][q] + xm[j] * g2[j][q];
                  ga[q] = v; }
              { const bool b5 = lane >= 32, b4 = (lane >> 4) & 1, b3 = (lane >> 3) & 1;
#pragma unroll
                for (int q = 0; q < 4; ++q) { const float snd = b5 ? ga[q] : ga[q + 4]; const float rcv = SHX(snd, 32); ga[q] = (b5 ? ga[q + 4] : ga[q]) + rcv; }
#pragma unroll
                for (int q = 0; q < 2; ++q) { const float snd = b4 ? ga[q] : ga[q + 2]; const float rcv = SHX(snd, 16); ga[q] = (b4 ? ga[q + 2] : ga[q]) + rcv; }
                { const float snd = b3 ? ga[0] : ga[1]; const float rcv = SHX(snd, 8); ga[0] = (b3 ? ga[1] : ga[0]) + rcv; }
                ga[0] += SHX(ga[0], 4); ga[0] += SHX(ga[0], 2); ga[0] += SHX(ga[0], 1); }
              if ((lane & 7) == 0) F.gates[(size_t)m * 8 + gq] = ga[0] + bgl; }
            v4u o; o.x = pk2(a[0], a[1]); o.y = pk2(a[2], a[3]); o.z = pk2(a[4], a[5]); o.w = pk2(a[6], a[7]);
            *(GAS v4u*)(F.XC + (size_t)m * 512 + c0) = o;
        }
    }
}
__device__ __forceinline__ void hgrn_prep_phase(Frame& F, int l) {
    LANE_SETUP
    const int gw = F.vcu * NWAVES + wave, NGW = F.G * NWAVES, tg = lane >> 3, cg = lane & 7;
    GAS float* hdec = (GAS float*)(F.ws + WS_HDEC);
    for (int it = gw; it < NB * 64 * 4; it += NGW) {
        const int h = it & 3, cn = it >> 2, ch0 = h * 64 + cg * 8;
        float lb[8];
#pragma unroll
        for (int j = 0; j < 8; ++j) lb[j] = F.par[PAR_LBV + l * 256 + ch0 + j];
        GAS bf16* base = F.P + (size_t)(cn * 32 + 4 * tg) * DIN + ch0;
        v4u qv[4], fv[4];
#pragma unroll
        for (int i = 0; i < 4; ++i) { qv[i] = *(const GAS v4u*)(base + (size_t)i * DIN + PC_Q); fv[i] = *(const GAS v4u*)(base + (size_t)i * DIN + PC_F); }
        float lf[4][8], kk[4][8], qs[4][8], pre[8];
#pragma unroll
        for (int i = 0; i < 4; ++i) {
            const float fr[8] = {pg8::bf_lo(fv[i].x), pg8::bf_hi(fv[i].x), pg8::bf_lo(fv[i].y), pg8::bf_hi(fv[i].y), pg8::bf_lo(fv[i].z), pg8::bf_hi(fv[i].z), pg8::bf_lo(fv[i].w), pg8::bf_hi(fv[i].w)};
            const float qr[8] = {pg8::bf_lo(qv[i].x), pg8::bf_hi(qv[i].x), pg8::bf_lo(qv[i].y), pg8::bf_hi(qv[i].y), pg8::bf_lo(qv[i].z), pg8::bf_hi(qv[i].z), pg8::bf_lo(qv[i].w), pg8::bf_hi(qv[i].w)};
#pragma unroll
            for (int j = 0; j < 8; ++j) { const float e = __expf(-fr[j]), rc = frcp(1.0f + e), omlb = 1.0f - lb[j];
                const float f = lb[j] + omlb * rc; kk[i][j] = omlb * e * rc; qs[i][j] = qr[j] * fsigmoid(qr[j]);
                lf[i][j] = __logf(f) + (i ? lf[i - 1][j] : 0.f); }
        }
#pragma unroll
        for (int j = 0; j < 8; ++j) { float s = lf[3][j];
#pragma unroll
            for (int o = 8; o < 64; o <<= 1) { const float v = SHUP(s, o); if (lane >= o) s += v; }
            pre[j] = s - lf[3][j]; }
#pragma unroll
        for (int i = 0; i < 4; ++i) { float oq[8], of[8];
#pragma unroll
            for (int j = 0; j < 8; ++j) { const float bt = pre[j] + lf[i][j], eb = __expf(bt); oq[j] = qs[i][j] * eb; of[j] = kk[i][j] * frcp(eb); }
            v4u wq, wf; wq.x = cvtpk(oq[0], oq[1]); wq.y = cvtpk(oq[2], oq[3]); wq.z = cvtpk(oq[4], oq[5]); wq.w = cvtpk(oq[6], oq[7]);
            wf.x = cvtpk(of[0], of[1]); wf.y = cvtpk(of[2], of[3]); wf.z = cvtpk(of[4], of[5]); wf.w = cvtpk(of[6], of[7]);
            *(GAS v4u*)(base + (size_t)i * DIN + PC_Q) = wq; *(GAS v4u*)(base + (size_t)i * DIN + PC_F) = wf; }
        if (tg == 7) { f32x4 d0, d1;
#pragma unroll
            for (int j = 0; j < 4; ++j) { d0[j] = __expf(pre[j] + lf[3][j]); d1[j] = __expf(pre[4 + j] + lf[3][4 + j]); }
            *(GAS f32x4*)(hdec + (size_t)cn * 256 + ch0) = d0; *(GAS f32x4*)(hdec + (size_t)cn * 256 + ch0 + 4) = d1; }
    }
}
__device__ __forceinline__ void final_phase(Frame& F) {
    LANE_SETUP
    const int gw = F.vcu * NWAVES + wave, NGW = F.G * NWAVES; const GAS float* ss = ss_arr(F, 4); const float* g = F.in[28];
    f32x4 gv[4];
#pragma unroll
    for (int j = 0; j < 4; ++j) gv[j] = *(const GAS f32x4*)(g + 256 * j + lane * 4);
#pragma unroll 4
    for (int m = gw; m < T; m += NGW) { const float rs = pg8::row_rs(ss, m);
        const GAS u32x2* xr = (const GAS u32x2*)(F.XB + (size_t)m * D) + lane; GAS f32x4* orow = (GAS f32x4*)(F.out + (size_t)m * D) + lane;
#pragma unroll
        for (int j = 0; j < 4; ++j) { const u32x2 w = xr[64 * j]; f32x4 v = (f32x4){pg8::bf_lo(w.x), pg8::bf_hi(w.x), pg8::bf_lo(w.y), pg8::bf_hi(w.y)}; v = v * rs * gv[j]; orow[64 * j] = v; } }
}

typedef float f32x16 __attribute__((ext_vector_type(16)));
typedef short v4i16_t __attribute__((ext_vector_type(4)));
#define MFMA32(a, b, c) __builtin_amdgcn_mfma_f32_32x32x16_bf16(a, b, c, 0, 0, 0)
__device__ __forceinline__ bf16x8 fragR(const LAS unsigned char* tile, int rs, int r0, int k0, int lane) {
    return *(const LAS bf16x8*)(tile + (r0 + (lane & 31)) * rs + (k0 + 8 * (lane >> 5)) * 2);
}
__device__ __forceinline__ bf16x8 fragT(const LAS unsigned char* tile, int rs, int k0, int n0, int lane) {
    const int hb = lane >> 5, g = (lane >> 4) & 1, q = (lane & 15) >> 2, p = lane & 3;
    const LAS unsigned char* a = tile + (k0 + 8 * hb + q) * rs + (n0 + 16 * g + 4 * p) * 2;
    const v4i16_t lo = __builtin_amdgcn_ds_read_tr16_b64_v4i16((LAS v4i16_t*)a);
    const v4i16_t hi = __builtin_amdgcn_ds_read_tr16_b64_v4i16((LAS v4i16_t*)(a + 4 * rs));
    return (bf16x8){lo[0], lo[1], lo[2], lo[3], hi[0], hi[1], hi[2], hi[3]};
}
__device__ __forceinline__ void storeT(LAS unsigned char* tile, int rs, int c0, int r0, const f32x16& a, int lane) {
    LAS unsigned char* p = tile + (c0 + (lane & 31)) * rs + (r0 + 4 * (lane >> 5)) * 2;
#pragma unroll
    for (int g = 0; g < 4; ++g) { u32x2 w; w.x = cvtpk(a[4 * g], a[4 * g + 1]); w.y = cvtpk(a[4 * g + 2], a[4 * g + 3]); *(LAS u32x2*)(p + 16 * g) = w; }
}
__device__ __forceinline__ bf16x8 pack8(const float* s, float sc) {
    v4u w; w.x = pk2(s[0] * sc, s[1] * sc); w.y = pk2(s[2] * sc, s[3] * sc); w.z = pk2(s[4] * sc, s[5] * sc); w.w = pk2(s[6] * sc, s[7] * sc); return __builtin_bit_cast(bf16x8, w);
}
#define ROW_OF(i, hb) (((i) & 3) + 8 * ((i) >> 2) + 4 * (hb))

__device__ __forceinline__ void s5_task(Frame& F, int l, int item, LAS unsigned char* wl) {
    LANE_SETUP
    const int seg = item & 1, bg_ = item >> 1, b = bg_ >> 4, g = bg_ & 15, lg = l * 16 + g, r = lane & 31, hb = lane >> 5;
    const int t_full = seg * (SEQ / 2), t_end = t_full + SEQ / 2;
    bf16x8 Bf[4], Cf[8];
#pragma unroll
    for (int ct = 0; ct < 4; ++ct) { const int p = (ct & 1) * 32 + r; Bf[ct] = pack8((const float*)F.par + PAR_S5BB + (lg * 64 + p) * 32 + (ct >> 1) * 16 + 8 * hb, 1.0f); }
#pragma unroll
    for (int ks = 0; ks < 8; ++ks) { const int c0 = 16 * ks + 8 * hb; const float* src = (c0 < 64 ? F.in[10] : F.in[11]) + ((size_t)lg * 16 + (r & 15)) * 64 + (c0 & 63);
        Cf[ks] = pack8(src, r < 16 ? (c0 < 64 ? 1.0f : -1.0f) : 0.0f); }
    const float ar = F.par[PAR_S5A + (lg * 64 + lane) * 2], ai = F.par[PAR_S5A + (lg * 64 + lane) * 2 + 1];
    const int et = lane >> 1, ehf = lane & 1;
    float dd[8];
#pragma unroll
    for (int j = 0; j < 8; ++j) dd[j] = F.in[12][l * 256 + g * 16 + 8 * ehf + j];
    LAS float* Ysc = (LAS float*)(wl + 10240);
    float xr = 0.f, xi = 0.f;
    const GAS bf16* Ub = F.P + (size_t)(b * SEQ) * DIN + PC_U + g * 16;
    const int tok = 16 * ((r >> 2) & 1) + (r & 3) + 4 * (r >> 3);
    bf16x8 Af = *(const GAS bf16x8*)(Ub + (size_t)tok * DIN + 8 * hb);
    v4u Uf = *(const GAS v4u*)(Ub + (size_t)et * DIN + 8 * ehf);
    for (int t0 = 0; t0 < t_end; t0 += 32) {
        const bf16x8 Acur = Af; const v4u Ucur = Uf; const bool full = t0 >= t_full;
        if (t0 + 32 < t_end) { Af = *(const GAS bf16x8*)(Ub + (size_t)(t0 + 32 + tok) * DIN + 8 * hb); Uf = *(const GAS v4u*)(Ub + (size_t)(t0 + 32 + et) * DIN + 8 * ehf); }
        f32x16 acc[4];
#pragma unroll
        for (int ct = 0; ct < 4; ++ct) { f32x16 z; for (int i = 0; i < 16; ++i) z[i] = 0.f; acc[ct] = MFMA32(Acur, Bf[ct], z); }
#pragma unroll
        for (int pr = 0; pr < 2; ++pr)
#pragma unroll
            for (int i = 0; i < 16; ++i) { auto rr = __builtin_amdgcn_permlane32_swap(__float_as_uint(acc[2 * pr][i]), __float_as_uint(acc[2 * pr + 1][i]), false, false);
                acc[2 * pr][i] = __uint_as_float(rr[0]); acc[2 * pr + 1][i] = __uint_as_float(rr[1]); }
#pragma unroll
        for (int hf = 0; hf < 2; ++hf)
#pragma unroll
            for (int i = 0; i < 16; ++i) { const float nr = ar * xr - ai * xi + acc[hf][i], ni = ar * xi + ai * xr + acc[2 + hf][i]; xr = nr; xi = ni; acc[hf][i] = nr; acc[2 + hf][i] = ni; }
        if (!full) continue;
#pragma unroll
        for (int part = 0; part < 2; ++part)
#pragma unroll
            for (int q4 = 0; q4 < 4; ++q4) { const f32x16& a = acc[2 * part + (q4 >> 1)]; const int o = (q4 & 1) * 8;
                v4u w; w.x = cvtpk(a[o + 0], a[o + 1]); w.y = cvtpk(a[o + 2], a[o + 3]); w.z = cvtpk(a[o + 4], a[o + 5]); w.w = cvtpk(a[o + 6], a[o + 7]);
                *(LAS v4u*)(wl + (part * 64 + lane) * 80 + q4 * 16) = w; }
        LDS_WAIT(); __builtin_amdgcn_wave_barrier();
        f32x16 y; for (int i = 0; i < 16; ++i) y[i] = 0.f;
#pragma unroll
        for (int ks = 0; ks < 8; ++ks) y = MFMA32(fragT(wl, 80, 16 * ks, 0, lane), Cf[ks], y);
        if (r < 16) {
#pragma unroll
            for (int i = 0; i < 16; ++i) Ysc[ROW_OF(i, hb) * 16 + r] = y[i];
        }
        LDS_WAIT(); __builtin_amdgcn_wave_barrier();
        { const f32x4 ya = *(const LAS f32x4*)(Ysc + et * 16 + 8 * ehf), yb = *(const LAS f32x4*)(Ysc + et * 16 + 8 * ehf + 4);
          float o[8];
          o[0] = gelu_tanh(ya.x + dd[0] * pg8::bf_lo(Ucur.x)); o[1] = gelu_tanh(ya.y + dd[1] * pg8::bf_hi(Ucur.x)); o[2] = gelu_tanh(ya.z + dd[2] * pg8::bf_lo(Ucur.y)); o[3] = gelu_tanh(ya.w + dd[3] * pg8::bf_hi(Ucur.y));
          o[4] = gelu_tanh(yb.x + dd[4] * pg8::bf_lo(Ucur.z)); o[5] = gelu_tanh(yb.y + dd[5] * pg8::bf_hi(Ucur.z)); o[6] = gelu_tanh(yb.z + dd[6] * pg8::bf_lo(Ucur.w)); o[7] = gelu_tanh(yb.w + dd[7] * pg8::bf_hi(Ucur.w));
          v4u w4; w4.x = cvtpk(o[0], o[1]); w4.y = cvtpk(o[2], o[3]); w4.z = cvtpk(o[4], o[5]); w4.w = cvtpk(o[6], o[7]);
          *(GAS v4u*)(F.YS5 + (size_t)(b * SEQ + t0 + et) * 256 + g * 16 + 8 * ehf) = w4; }
        LDS_WAIT(); __builtin_amdgcn_wave_barrier();
    }
}


__device__ __forceinline__ void hgrn_task(Frame& F, int l, int item, LAS unsigned char* wl) {
    LANE_SETUP
    const int seg = item & 1, bh_ = item >> 1, b = bh_ >> 2, h = bh_ & 3, r = lane & 31, hb = lane >> 5;
    const int t_full = seg * (SEQ / 2), t_end = t_full + SEQ / 2;
    const int et = lane & 31, ehf = lane >> 5;
    constexpr int RS = 144, TSZ = 32 * RS;
    LAS unsigned char *Tq = wl, *Tf = wl + TSZ, *Ti = wl + 2 * TSZ, *Tg = wl + 3 * TSZ, *SC = wl + 4 * TSZ, *ST = SC + 2560;
    LAS float* dec = (LAS float*)(ST + 64 * RS);
    { unsigned z0 = 0u; asm volatile("" : "+v"(z0));
      for (int i = lane; i < 64 * RS / 16; i += 64) *(LAS v4u*)(ST + i * 16) = (v4u){z0, z0, z0, z0}; }
    f32x16 S[2][2];
#pragma unroll
    for (int db = 0; db < 2; ++db)
#pragma unroll
        for (int eb = 0; eb < 2; ++eb) for (int i = 0; i < 16; ++i) S[db][eb][i] = 0.f;
    const int lt = lane >> 3, lc = lane & 7;
    const GAS bf16* Pb = F.P + (size_t)(b * SEQ) * DIN + h * 64 + lc * 8;
    const float* hdec = (const float*)(F.ws + WS_HDEC) + (size_t)(b * 64) * 256 + h * 64 + lane;
    v4u pre[3][4];
#pragma unroll
    for (int a = 0; a < 3; ++a)
#pragma unroll
        for (int k = 0; k < 4; ++k) pre[a][k] = *(const GAS v4u*)(Pb + (size_t)(lt + 8 * k) * DIN + a * 256);
    float dpre = hdec[0];
    for (int t0 = 0; t0 < t_end; t0 += 32) {
        const bool full = t0 >= t_full;
#pragma unroll
        for (int a = 0; a < 3; ++a)
#pragma unroll
            for (int k = 0; k < 4; ++k) *(LAS v4u*)(wl + a * TSZ + (lt + 8 * k) * RS + lc * 16) = pre[a][k];
        dec[lane] = dpre;
        if (t0 + 32 < t_end) {
#pragma unroll
            for (int a = 0; a < 3; ++a)
#pragma unroll
                for (int k = 0; k < 4; ++k) pre[a][k] = *(const GAS v4u*)(Pb + (size_t)(t0 + 32 + lt + 8 * k) * DIN + a * 256);
            dpre = hdec[(size_t)((t0 >> 5) + 1) * 256];
        }
        LDS_WAIT(); __builtin_amdgcn_wave_barrier();
        f32x16 O[2];
        if (full) {
        f32x16 X; for (int i = 0; i < 16; ++i) X[i] = 0.f;
#pragma unroll
        for (int ks = 0; ks < 4; ++ks) X = MFMA32(fragR(Tf, RS, 0, 16 * ks, lane), fragR(Tq, RS, 0, 16 * ks, lane), X);
#pragma unroll
        for (int i = 0; i < 16; ++i) if (ROW_OF(i, hb) > r) X[i] = 0.f;
        storeT(SC, 80, 0, 0, X, lane);
        LDS_WAIT(); __builtin_amdgcn_wave_barrier();
#pragma unroll
        for (int eb = 0; eb < 2; ++eb) { for (int i = 0; i < 16; ++i) O[eb][i] = 0.f;
#pragma unroll
            for (int ks = 0; ks < 2; ++ks) O[eb] = MFMA32(fragR(SC, 80, 0, 16 * ks, lane), fragT(Ti, RS, 16 * ks, 32 * eb, lane), O[eb]);
#pragma unroll
            for (int ks = 0; ks < 4; ++ks) O[eb] = MFMA32(fragR(Tq, RS, 0, 16 * ks, lane), fragR(ST, RS, 32 * eb, 16 * ks, lane), O[eb]); }
        }
#pragma unroll
        for (int db = 0; db < 2; ++db)
#pragma unroll
            for (int eb = 0; eb < 2; ++eb)
#pragma unroll
                for (int ks = 0; ks < 2; ++ks) S[db][eb] = MFMA32(fragT(Tf, RS, 16 * ks, 32 * db, lane), fragT(Ti, RS, 16 * ks, 32 * eb, lane), S[db][eb]);
        LDS_WAIT(); __builtin_amdgcn_wave_barrier();
#pragma unroll
        for (int db = 0; db < 2; ++db) {
#pragma unroll
            for (int i = 0; i < 16; ++i) { const float d = dec[32 * db + ROW_OF(i, hb)]; S[db][0][i] *= d; S[db][1][i] *= d; }
            storeT(ST, RS, 0, 32 * db, S[db][0], lane); storeT(ST, RS, 32, 32 * db, S[db][1], lane); }
        LDS_WAIT(); __builtin_amdgcn_wave_barrier();
        if (full) { LAS float* Of = (LAS float*)wl;
#pragma unroll
          for (int eb = 0; eb < 2; ++eb)
#pragma unroll
              for (int i = 0; i < 16; ++i) Of[ROW_OF(i, hb) * 68 + 32 * eb + r] = O[eb][i];
          LDS_WAIT(); __builtin_amdgcn_wave_barrier();
          GAS bf16* op = F.MIX + (size_t)(b * SEQ + t0 + et) * 1024 + h * 64 + 32 * ehf;
#pragma unroll
          for (int c4 = 0; c4 < 4; ++c4) { const f32x4 va = *(const LAS f32x4*)(Of + et * 68 + 32 * ehf + 8 * c4), vb = *(const LAS f32x4*)(Of + et * 68 + 32 * ehf + 8 * c4 + 4);
              v4u w4; w4.x = cvtpk(va.x, va.y); w4.y = cvtpk(va.z, va.w); w4.z = cvtpk(vb.x, vb.y); w4.w = cvtpk(vb.z, vb.w);
              *(GAS v4u*)(op + 8 * c4) = w4; } }
        LDS_WAIT(); __builtin_amdgcn_wave_barrier();
    }
}


__device__ __forceinline__ void mlstm_task(Frame& F, int l, int item) {
    LANE_SETUP
    const int seg = item & 1, bh_ = item >> 1, b = bh_ >> 2, h = bh_ & 3, w = wave, r = lane & 31, hb = lane >> 5;
    const int n_full = seg * 16, n_end = n_full + 16;
    constexpr int RS = 272, TS = 64 * RS;
    constexpr int RST = 320, TST = 64 * RST;
    LAS unsigned char *Qt = F.lds, *Kt = Qt + TS, *Kw = Kt + TS, *Vt = Kw + TST, *Wt = Vt + TST, *CT = Wt + 64 * 144, *Hs = Kt;
    LAS float* gLF = (LAS float*)(CT + 128 * RS);
    LAS float* gIG = gLF + 1024;
    LAS float* gGM = (LAS float*)(F.lds + LDSCTL_OFF + 6144);
    LAS float* dnp = (LAS float*)(F.lds + LDSCTL_OFF + 10240);
    LAS float* sc_ = (LAS float*)(F.lds + LDSCTL_OFF + 1024);
    LAS float *sA = sc_, *sM = sc_ + 128, *sW = sc_ + 256, *sSC = sc_ + 384, *sEM = sc_ + 512, *sSP = sc_ + 640, *RSUM = sc_ + 648, *QN = sc_ + 776, *nbuf = sc_ + 840, *cstat = sc_ + 1096;
    { unsigned z0 = 0u; asm volatile("" : "+v"(z0));
      for (int i = tid; i < 128 * RS / 16; i += 512) *(LAS v4u*)(CT + i * 16) = (v4u){z0, z0, z0, z0};
      if (tid < 256) nbuf[tid] = __uint_as_float(z0); }
    f32x16 C[2];
#pragma unroll
    for (int j = 0; j < 2; ++j) for (int i = 0; i < 16; ++i) C[j][i] = 0.f;
    float m_prev = 0.f;
    const int lrow = tid >> 3, lc16 = (tid & 7) * 2;
    const int tb = w >> 2, eb = w & 3;
    const GAS bf16* Qg = F.QKV + (size_t)(b * SEQ) * 1536 + h * 128;
    const GAS float* gg = F.gates + (size_t)(b * SEQ) * 8;
    LAS float* pLF = (LAS float*)(Qt);
    LAS float* pIG = pLF + 1024;
    for (int t = tid; t < 1024; t += 512) { const GAS float* gp = gg + (size_t)(n_full * 64 + t) * 8; const float fg = gp[4 + h]; gLF[t] = fminf(fg, 0.f) - log1pf(__expf(-fabsf(fg))); gIG[t] = gp[h]; }
    if (seg) for (int t = tid; t < 1024; t += 512) { const GAS float* gp = gg + (size_t)t * 8; const float fg = gp[4 + h]; pLF[t] = fminf(fg, 0.f) - log1pf(__expf(-fabsf(fg))); pIG[t] = gp[h]; }
    v4u pq[2], pk[2], pv[2];
#pragma unroll
    for (int j = 0; j < 2; ++j) { const GAS bf16* s = Qg + (size_t)lrow * 1536 + (lc16 + j) * 8; pq[j] = *(const GAS v4u*)s; pk[j] = *(const GAS v4u*)(s + 512); pv[j] = *(const GAS v4u*)(s + 1024); }
    __syncthreads();
    if (seg) {
        float bloc[2], igv[2];
#pragma unroll
        for (int c2 = 0; c2 < 2; ++c2) { const int c = 2 * w + c2; float bc = pLF[c * 64 + lane]; igv[c2] = pIG[c * 64 + lane];
#pragma unroll
            for (int o = 1; o < 64; o <<= 1) { const float v = SHUP(bc, o); if (lane >= o) bc += v; }
            bloc[c2] = bc; if (lane == 63) cstat[c] = bc; }
        __syncthreads();
        float Btot = 0.f, off0 = 0.f, off1 = 0.f;
#pragma unroll
        for (int c = 0; c < 16; ++c) { const float v = cstat[c]; if (c < 2 * w) off0 += v; if (c < 2 * w + 1) off1 += v; Btot += v; }
        float amax;
        { const float a0 = igv[0] - (bloc[0] + off0), a1 = igv[1] - (bloc[1] + off1);
          gGM[(2 * w) * 64 + lane] = a0; gGM[(2 * w + 1) * 64 + lane] = a1;
          float mx = fmaxf(a0, a1);
#pragma unroll
          for (int o = 1; o < 64; o <<= 1) mx = fmaxf(mx, SHX(mx, o));
          if (lane == 0) cstat[16 + w] = mx; }
        __syncthreads();
        amax = cstat[16];
#pragma unroll
        for (int c = 1; c < 8; ++c) amax = fmaxf(amax, cstat[16 + c]);
        const float m16 = Btot + fmaxf(0.f, amax), wofs = Btot - m16;
        m_prev = m16;
        float na0 = 0.f, na1 = 0.f;
        for (int n = 0; n < 16; ++n) {
            LAS unsigned char* Kb = (n & 1) ? Qt : Kw; LAS unsigned char* Vb = (n & 1) ? Wt : Vt;
            { const float wrow = __expf(gGM[n * 64 + lrow] + wofs);
#pragma unroll
              for (int j = 0; j < 2; ++j) { const int o = lrow * RST + (lc16 + j) * 16;
                  *(LAS v4u*)(Vb + o) = pv[j];
                  v4u kw; kw.x = pk2(pg8::bf_lo(pk[j].x) * wrow, pg8::bf_hi(pk[j].x) * wrow); kw.y = pk2(pg8::bf_lo(pk[j].y) * wrow, pg8::bf_hi(pk[j].y) * wrow);
                  kw.z = pk2(pg8::bf_lo(pk[j].z) * wrow, pg8::bf_hi(pk[j].z) * wrow); kw.w = pk2(pg8::bf_lo(pk[j].w) * wrow, pg8::bf_hi(pk[j].w) * wrow);
                  *(LAS v4u*)(Kb + o) = kw; } }
            __syncthreads();
#pragma unroll
            for (int j = 0; j < 2; ++j) { const GAS bf16* s = Qg + (size_t)((n + 1) * 64 + lrow) * 1536 + (lc16 + j) * 8; pq[j] = *(const GAS v4u*)s; pk[j] = *(const GAS v4u*)(s + 512); pv[j] = *(const GAS v4u*)(s + 1024); }
#pragma unroll
            for (int s = 0; s < 8; ++s) { const unsigned kv = *(const LAS unsigned*)(Kb + (8 * w + s) * RST + lane * 4); na0 += pg8::bf_lo(kv); na1 += pg8::bf_hi(kv); }
#pragma unroll
            for (int j = 0; j < 2; ++j) { const int db = 2 * tb + j;
#pragma unroll
                for (int ks = 0; ks < 4; ++ks) C[j] = MFMA32(fragT(Kb, RST, 16 * ks, 32 * db, lane), fragT(Vb, RST, 16 * ks, 32 * eb, lane), C[j]); }
        }
        __syncthreads();
        dnp[w * 128 + 2 * lane] = na0; dnp[w * 128 + 2 * lane + 1] = na1;
        __syncthreads();
        if (w == 5) { float s0 = 0.f, s1 = 0.f;
#pragma unroll
            for (int q = 0; q < 8; ++q) { s0 += dnp[q * 128 + 2 * lane]; s1 += dnp[q * 128 + 2 * lane + 1]; }
            nbuf[2 * lane] = s0; nbuf[2 * lane + 1] = s1; }
#pragma unroll
        for (int j = 0; j < 2; ++j) storeT(CT, RS, 32 * eb, 32 * (2 * tb + j), C[j], lane);
        __syncthreads();
    }
    { if (seg) __syncthreads();
#pragma unroll
      for (int c2 = 0; c2 < 2; ++c2) { const int c = 2 * w + c2; float bc = gLF[c * 64 + lane]; const float ig = gIG[c * 64 + lane];
#pragma unroll
          for (int o = 1; o < 64; o <<= 1) { const float v = SHUP(bc, o); if (lane >= o) bc += v; }
          const float ap = ig - bc; float gm = ap;
#pragma unroll
          for (int o = 1; o < 64; o <<= 1) { const float v = SHUP(gm, o); if (lane >= o) gm = fmaxf(gm, v); }
          gLF[c * 64 + lane] = bc; gIG[c * 64 + lane] = ap; gGM[c * 64 + lane] = gm; }
      __syncthreads(); }
#define MLSTM_SCALARS(nn) do { const int nb_ = (nn) & 1, cl_ = ((nn) - n_full) * 64; const float bc = gLF[cl_ + lane], ap = gIG[cl_ + lane], gm = gGM[cl_ + lane], blast = gLF[cl_ + 63], g63 = gGM[cl_ + 63]; \
        const float M = fmaxf(gm, m_prev), mt = bc + M, m_new = fmaxf(blast + m_prev, blast + g63); \
        sA[nb_ * 64 + lane] = ap; sM[nb_ * 64 + lane] = M; sW[nb_ * 64 + lane] = __expf(blast + ap - m_new); sSC[nb_ * 64 + lane] = __expf(m_prev - M); sEM[nb_ * 64 + lane] = __expf(-mt); \
        if (lane == 0) sSP[nb_] = __expf(blast + m_prev - m_new); m_prev = m_new; } while (0)
    if (w == 7) MLSTM_SCALARS(n_full);
    __syncthreads();
    for (int n = n_full; n < n_end; ++n) {
        const int buf = n & 1, t0 = n * 64; const bool more = (n + 1 < n_end);
        const float sp = sSP[buf];
        { const float wrow = sW[buf * 64 + lrow];
#pragma unroll
          for (int j = 0; j < 2; ++j) { const int o = lrow * RS + (lc16 + j) * 16, ot = lrow * RST + (lc16 + j) * 16;
              *(LAS v4u*)(Qt + o) = pq[j]; *(LAS v4u*)(Kt + o) = pk[j]; *(LAS v4u*)(Vt + ot) = pv[j];
              v4u kw; kw.x = pk2(pg8::bf_lo(pk[j].x) * wrow, pg8::bf_hi(pk[j].x) * wrow); kw.y = pk2(pg8::bf_lo(pk[j].y) * wrow, pg8::bf_hi(pk[j].y) * wrow);
              kw.z = pk2(pg8::bf_lo(pk[j].z) * wrow, pg8::bf_hi(pk[j].z) * wrow); kw.w = pk2(pg8::bf_lo(pk[j].w) * wrow, pg8::bf_hi(pk[j].w) * wrow);
              *(LAS v4u*)(Kw + ot) = kw; } }
        __syncthreads();
        if (more) {
#pragma unroll
            for (int j = 0; j < 2; ++j) { const GAS bf16* s = Qg + (size_t)(t0 + 64 + lrow) * 1536 + (lc16 + j) * 8; pq[j] = *(const GAS v4u*)s; pk[j] = *(const GAS v4u*)(s + 512); pv[j] = *(const GAS v4u*)(s + 1024); }
        }
        if (w == 7 && more) MLSTM_SCALARS(n + 1);
        const LAS float* nold = nbuf + buf * 128;
        {
          const float n0_ = nold[2 * lane], n1_ = nold[2 * lane + 1]; float a0 = 0.f, a1 = 0.f, qd[8];
#pragma unroll
          for (int s = 0; s < 8; ++s) { const unsigned kv = *(const LAS unsigned*)(Kw + (8 * w + s) * RST + lane * 4), qv = *(const LAS unsigned*)(Qt + (8 * w + s) * RS + lane * 4);
              a0 += pg8::bf_lo(kv); a1 += pg8::bf_hi(kv); qd[s] = pg8::bf_lo(qv) * n0_ + pg8::bf_hi(qv) * n1_; }
          dnp[w * 128 + 2 * lane] = a0; dnp[w * 128 + 2 * lane + 1] = a1;
#pragma unroll
          for (int o = 1; o < 64; o <<= 1)
#pragma unroll
              for (int s = 0; s < 8; ++s) qd[s] += SHX(qd[s], o);
          if (lane < 8) { float v = qd[0];
#pragma unroll
              for (int s = 1; s < 8; ++s) v = (lane == s) ? qd[s] : v;
              QN[8 * w + lane] = v; } }
        f32x16 num; for (int i = 0; i < 16; ++i) num[i] = 0.f;
        if (w < 4) {
            const int sb = w >> 1, xtb = w & 1;
            f32x16 X; for (int i = 0; i < 16; ++i) X[i] = 0.f;
            if (w != 2) {
#pragma unroll
                for (int ks = 0; ks < 8; ++ks) X = MFMA32(fragR(Kt, RS, 32 * sb, 16 * ks, lane), fragR(Qt, RS, 32 * xtb, 16 * ks, lane), X);
            }
            const int tcol = 32 * xtb + r; const float Mt = sM[buf * 64 + tcol]; float ps = 0.f;
#pragma unroll
            for (int i = 0; i < 16; ++i) { const int s = 32 * sb + ROW_OF(i, hb); const float d = (s <= tcol) ? __expf(sA[buf * 64 + s] - Mt) : 0.f; X[i] *= d; ps += X[i]; }
            ps += SHX(ps, 32);
            if (hb == 0) RSUM[sb * 64 + tcol] = ps;
            storeT(Wt, 144, 32 * xtb, 32 * sb, X, lane);
        } else {
#pragma unroll
            for (int ks = 0; ks < 8; ++ks) num = MFMA32(fragR(Qt, RS, 32 * tb, 16 * ks, lane), fragR(CT, RS, 32 * eb, 16 * ks, lane), num);
        }
        __syncthreads();
        if (w < 4) {
#pragma unroll
            for (int ks = 0; ks < 8; ++ks) num = MFMA32(fragR(Qt, RS, 32 * tb, 16 * ks, lane), fragR(CT, RS, 32 * eb, 16 * ks, lane), num);
        }
#pragma unroll
        for (int i = 0; i < 16; ++i) num[i] *= sSC[buf * 64 + 32 * tb + ROW_OF(i, hb)];
#pragma unroll
        for (int ks = 0; ks < 4; ++ks) num = MFMA32(fragR(Wt, 144, 32 * tb, 16 * ks, lane), fragT(Vt, RST, 16 * ks, 32 * eb, lane), num);
#pragma unroll
        for (int i = 0; i < 16; ++i) { const int t = 32 * tb + ROW_OF(i, hb); const float den = RSUM[t] + RSUM[64 + t] + sSC[buf * 64 + t] * QN[t];
            const float hv = num[i] * frcp(fmaxf(fabsf(den), sEM[buf * 64 + t]));
            *((LAS bf16*)(Hs + t * RS) + 32 * eb + r) = (bf16)f2bf(hv); }
        __syncthreads();
#pragma unroll
        for (int j = 0; j < 2; ++j) { const int db = 2 * tb + j;
#pragma unroll
            for (int i = 0; i < 16; ++i) C[j][i] *= sp;
#pragma unroll
            for (int ks = 0; ks < 4; ++ks) C[j] = MFMA32(fragT(Kw, RST, 16 * ks, 32 * db, lane), fragT(Vt, RST, 16 * ks, 32 * eb, lane), C[j]);
            if (more) storeT(CT, RS, 32 * eb, 32 * db, C[j], lane); }
        if (w == 5) { float s0 = 0.f, s1 = 0.f;
#pragma unroll
            for (int q = 0; q < 8; ++q) { s0 += dnp[q * 128 + 2 * lane]; s1 += dnp[q * 128 + 2 * lane + 1]; }
            LAS float* nnew = nbuf + (buf ^ 1) * 128;
            nnew[2 * lane] = sp * nold[2 * lane] + s0; nnew[2 * lane + 1] = sp * nold[2 * lane + 1] + s1; }
#pragma unroll
        for (int j = 0; j < 8; ++j) { const int t = 8 * w + j; const unsigned hv = *(const LAS unsigned*)(Hs + t * RS + lane * 4);
            *(GAS unsigned*)(F.MIX + (size_t)(b * SEQ + t0 + t) * 1024 + 512 + h * 128 + 2 * lane) = hv; }
        __syncthreads();
    }
#undef MLSTM_SCALARS
}

__device__ __forceinline__ void post_phase(Frame& F, int l, int wg0) {
    LANE_SETUP
    const int nwg = F.G - wg0, me = (int)blockIdx.x - wg0;
    if (me < 0 || nwg <= 0) return;
    const int gw = me * NWAVES + wave, NGW = nwg * NWAVES;
    const f32x4 hng = *(const GAS f32x4*)(F.in[4] + l * 256 + 4 * lane);
    const f32x4 mnga = *(const GAS f32x4*)(F.in[21] + l * 512 + 8 * lane), mngb = *(const GAS f32x4*)(F.in[21] + l * 512 + 8 * lane + 4);
    const f32x4 mska = *(const GAS f32x4*)(F.in[22] + l * 512 + 8 * lane), mskb = *(const GAS f32x4*)(F.in[22] + l * 512 + 8 * lane + 4);
#pragma unroll 4
    for (int m = gw; m < T; m += NGW) {
        GAS bf16* mr = F.MIX + (size_t)m * 1024;
        const u32x2 hv = *(const GAS u32x2*)(mr + 4 * lane), hg = *(const GAS u32x2*)(F.P + (size_t)m * DIN + PC_G + 4 * lane);
        const v4u mv = *(const GAS v4u*)(mr + 512 + 8 * lane), mx = *(const GAS v4u*)(F.XC + (size_t)m * 512 + 8 * lane), mz = *(const GAS v4u*)(F.P + (size_t)m * DIN + PC_MZ + 8 * lane);
        { float v[4] = {pg8::bf_lo(hv.x), pg8::bf_hi(hv.x), pg8::bf_lo(hv.y), pg8::bf_hi(hv.y)}; const float g[4] = {pg8::bf_lo(hg.x), pg8::bf_hi(hg.x), pg8::bf_lo(hg.y), pg8::bf_hi(hg.y)};
          float ss = (v[0] * v[0] + v[1] * v[1]) + (v[2] * v[2] + v[3] * v[3]);
          ss += SHX(ss, 1); ss += SHX(ss, 2); ss += SHX(ss, 4); ss += SHX(ss, 8);
          const float rs = frsq(ss * (1.0f / 64.0f) + EPS);
#pragma unroll
          for (int j = 0; j < 4; ++j) v[j] = v[j] * rs * hng[j] * g[j] * fsigmoid(g[j]);
          u32x2 o; o.x = cvtpk(v[0], v[1]); o.y = cvtpk(v[2], v[3]); *(GAS u32x2*)(mr + 4 * lane) = o; }
        { float v[8] = {pg8::bf_lo(mv.x), pg8::bf_hi(mv.x), pg8::bf_lo(mv.y), pg8::bf_hi(mv.y), pg8::bf_lo(mv.z), pg8::bf_hi(mv.z), pg8::bf_lo(mv.w), pg8::bf_hi(mv.w)};
          const float x[8] = {pg8::bf_lo(mx.x), pg8::bf_hi(mx.x), pg8::bf_lo(mx.y), pg8::bf_hi(mx.y), pg8::bf_lo(mx.z), pg8::bf_hi(mx.z), pg8::bf_lo(mx.w), pg8::bf_hi(mx.w)};
          const float z[8] = {pg8::bf_lo(mz.x), pg8::bf_hi(mz.x), pg8::bf_lo(mz.y), pg8::bf_hi(mz.y), pg8::bf_lo(mz.z), pg8::bf_hi(mz.z), pg8::bf_lo(mz.w), pg8::bf_hi(mz.w)};
          float ss = 0.f;
#pragma unroll
          for (int j = 0; j < 8; ++j) ss += v[j] * v[j];
          ss += SHX(ss, 1); ss += SHX(ss, 2); ss += SHX(ss, 4); ss += SHX(ss, 8);
          const float rs = frsq(ss * (1.0f / 128.0f) + EPS);
#pragma unroll
          for (int j = 0; j < 8; ++j) { const float ngj = j < 4 ? mnga[j & 3] : mngb[j & 3], skj = j < 4 ? mska[j & 3] : mskb[j & 3]; v[j] = (v[j] * rs * ngj + skj * x[j]) * (z[j] * fsigmoid(z[j])); }
          v4u o; o.x = cvtpk(v[0], v[1]); o.y = cvtpk(v[2], v[3]); o.z = cvtpk(v[4], v[5]); o.w = cvtpk(v[6], v[7]); *(GAS v4u*)(mr + 512 + 8 * lane) = o; }
    }
}

__device__ __forceinline__ void mixers_phase(Frame& F, int l) {
    LANE_SETUP
    const int bid = F.vcu;
    if (F.G != 256) return;
    if (bid < 128) { mlstm_task(F, l, bid);
        if (l == 0 && (bid & 1) == 0) {
            __syncthreads();
            weight_items(F, (LAS float*)(F.lds + RING_OFF + wave * 10240), (bid >> 1) * NWAVES + wave, 64 * NWAVES, W_ITEMS_SPLIT, W_ITEMS_ALL, lane); }
        return; }
    if (wave >= 5) {
        if (l == 0) weight_items(F, (LAS float*)(F.lds + RING_OFF + 98304 + (wave - 5) * 10240), (bid - 128) * 3 + (wave - 5), 128 * 3, W_ITEMS_EARLY, W_ITEMS_SPLIT, lane);
    }
    else if (wave == 0) hgrn_task(F, l, bid - 128, F.lds + RING_OFF);
    else s5_task(F, l, (bid - 128) * 4 + (wave - 1), F.lds + RING_OFF + 32768 + (wave - 1) * 16384);
    { XcdBarrier bar2; bar2.bar = (unsigned*)(F.ctl + CW_BAR) + XCD_BAR_WORDS; bar2.x = xb_xcc_id(); bar2.st = F.MISC + 10; bar2.gexp = 128u; xcd_barrier(bar2); }
    { pg8::Gemm g{(const bf16*)F.YS5, (const bf16*)(F.ws + WS_WGLU + l * WGLU_STRIDE), T, 256, 256, 256, 0, 0}; pg8::StaticOrder S; S.init(T, 256, 128, bid - 128);
      pg8::EpiGlu E{F.YS5, F.MIX, 1024, 256};
      pg8::gemm_phase<pg8::EpiGlu, pg8::StaticOrder, true, true>(F.lds + RING_OFF, g, S, E); }
}

struct Args { const float* in[29]; float* out; unsigned char* ws; int ph_lo, ph_hi; };
__global__ void __launch_bounds__(NWAVES * 64, 2) fwd_kernel(Args args) {
    extern __shared__ __attribute__((aligned(16))) unsigned char lds[];
    Frame F;
    F.lds = (LAS unsigned char*)lds;
    F.MISC = (volatile LAS unsigned*)(F.lds + MISC_OFF);
    F.G = gridDim.x; { const int bx = blockIdx.x; F.vcu = (F.G % 8 == 0) ? (bx % 8) * (F.G / 8) + bx / 8 : bx; }
    GAS unsigned char* ws = (GAS unsigned char*)args.ws;
#define SET_WS() do { asm volatile("" : "+s"(ws)); F.ws = ws; F.par = (GAS float*)(ws + WS_PAR); F.ss0 = (GAS float*)(ws + WS_SS); F.gates = (GAS float*)(ws + WS_GATES); \
    F.XB = (GAS bf16*)(ws + WS_XB); F.P = (GAS bf16*)(ws + WS_P); F.MID = (GAS bf16*)(ws + WS_MID); F.XC = (GAS bf16*)(ws + WS_XC); F.QKV = (GAS bf16*)(ws + WS_QKV); F.MIX = (GAS bf16*)(ws + WS_MIX); F.YS5 = (GAS bf16*)(ws + WS_YS5); } while (0)
    F.ctl = (gu32*)(ws + WS_CTL); F.in = args.in; F.out = (GAS float*)args.out; SET_WS();
    for (int u = threadIdx.x; u < (LDS_BYTES - LDSCTL_OFF) / 4; u += NWAVES * 64) ((LAS unsigned*)(F.lds + LDSCTL_OFF))[u] = 0u;
    __syncthreads();
    XcdBarrier bar; bar.bar = (unsigned*)(F.ctl + CW_BAR); bar.x = 0; bar.st = nullptr;
    const bool one_launch = (args.ph_hi - args.ph_lo) > 1;
    if (one_launch) bar = xcd_barrier_post((unsigned*)(F.ctl + CW_BAR), F.MISC + 8);
    if (F.vcu >= 128) (void)xcd_barrier_post((unsigned*)(F.ctl + CW_BAR) + XCD_BAR_WORDS, F.MISC + 10);

    int ph_lo = args.ph_lo, ph_hi = args.ph_hi;
    if (ph_lo == 0) { p0_prologue(F); ph_lo = 1; if (ph_lo < ph_hi) xcd_barrier(bar); }
    const bool do_final = (ph_hi == NPHASE); if (do_final) ph_hi = NPHASE - 1;
#ifndef REP_KIND
#define REP_KIND 0
#endif
#ifndef REV_DOWN
#define REV_DOWN 1
#endif
    int rep_mask = 0;
    for (int ph = ph_lo; ph < ph_hi; ++ph) {
        const int l = (ph - 1) / KPL, kidx = (ph - 1) % KPL, kind = kidx < 3 ? kidx + 1 : kidx + 2;
        SET_WS();
        PG8_LAS unsigned char* ring = F.lds + RING_OFF;
        if (kind == 1) {
            pg8::Gemm g{(const bf16*)F.XB, (const bf16*)(ws + WS_WIN + l * WIN_STRIDE), T, DIN, D, D, 0, 0}; pg8::StaticOrder S; S.init(T, DIN, F.G, (int)blockIdx.x); S.ss = ss_arr(F, l == 0 ? 0 : 2); S.rsl = (PG8_LAS float*)(F.lds + LDSCTL_OFF + 8192);
            pg8::EpiScaleBf16 E{F.P, DIN, S.rsl};
            pg8::gemm_phase<pg8::EpiScaleBf16, pg8::StaticOrder, true, true>(ring, g, S, E);
        } else if (kind == 2) { prep_phase(F, l); if (!(REP_KIND == 2 && ((rep_mask >> l) & 1))) hgrn_prep_phase(F, l); }
        else if (kind == 3) {
            for (int s = 0; s < 2; ++s) {
                pg8::Gemm g{s == 0 ? (const bf16*)F.XC : (const bf16*)(F.P + PC_MX), s == 0 ? (const bf16*)(ws + WS_WQK + l * WQK_STRIDE) : (const bf16*)(ws + WS_WV + l * WV_STRIDE), T, s == 0 ? 1024 : 512, 256, s == 0 ? 512 : DIN, 1, 256};
                pg8::StaticOrder S; S.init(T, g.N, F.G, (int)blockIdx.x);
                pg8::EpiScaleBf16 E{F.QKV + (s == 0 ? 0 : 1024), 1536, nullptr};
                pg8::gemm_phase<pg8::EpiScaleBf16, pg8::StaticOrder, true, true>(ring, g, S, E);
            }
        }
        else if (kind == 5) mixers_phase(F, l);
        else if (kind == 6) { post_phase(F, l, 0);
        } else if (kind == 7 || kind == 9) {
            pg8::Gemm g{kind == 7 ? (const bf16*)F.MIX : (const bf16*)F.MID, kind == 7 ? (const bf16*)(ws + WS_WOUT + l * WOUT_STRIDE) : (const bf16*)(ws + WS_WD + l * WD_STRIDE), T, D, kind == 7 ? D : DFF, kind == 7 ? D : DFF, 0, 0};
            pg8::StaticOrder S; S.init(T, D, F.G, (int)blockIdx.x); S.rev = (kind == 9) ? REV_DOWN : 0;
            pg8::EpiResid E{(kind == 7 && l == 0) ? (const GAS float*)F.in[0] : (const GAS float*)nullptr, F.XB, ss_arr(F, 2 * l + (kind == 7 ? 1 : 2))};
            pg8::gemm_phase<pg8::EpiResid, pg8::StaticOrder, true, true>(ring, g, S, E);
        } else if (kind == 8) {
            pg8::Gemm g{(const bf16*)F.XB, (const bf16*)(ws + WS_WGU + l * WGU_STRIDE), T, 2 * DFF, D, D, 0, 0}; pg8::StaticOrder S; S.init(T, 2 * DFF, F.G, (int)blockIdx.x); S.ss = ss_arr(F, 2 * l + 1); S.rsl = (PG8_LAS float*)(F.lds + LDSCTL_OFF + 8192);
            pg8::EpiSwiglu E{F.MID, DFF, S.rsl};
            pg8::gemm_phase<pg8::EpiSwiglu, pg8::StaticOrder, true, true>(ring, g, S, E);
        }
        if (ph + 1 < ph_hi || do_final) xcd_barrier(bar);
        if (REP_KIND != 0 && kind == REP_KIND && !(rep_mask & (1 << l))) { rep_mask |= 1 << l; --ph; }
    }
    if (do_final) { SET_WS(); final_phase(F); }
}

extern "C" void kernel_launch(void* const* d_in, const int* in_sizes, int n_in, void* d_out, int out_size, void* d_ws, size_t ws_size, hipStream_t stream) {
    static int grid = 0;
    if (grid == 0) {
        if (n_in != 29 || in_sizes[0] != T * D || out_size != T * D || ws_size < WS_END) { fprintf(stderr, "kernel_launch: unexpected shapes (n_in %d in0 %d out %d ws %zu)\n", n_in, n_in > 0 ? in_sizes[0] : -1, out_size, ws_size); grid = -1; return; }
        int dev = 0, cus = 0, per_cu = 0;
        if (hipGetDevice(&dev) != hipSuccess || hipDeviceGetAttribute(&cus, hipDeviceAttributeMultiprocessorCount, dev) != hipSuccess) { grid = -1; return; }
        if (hipFuncSetAttribute((const void*)fwd_kernel, hipFuncAttributeMaxDynamicSharedMemorySize, LDS_BYTES) != hipSuccess) { fprintf(stderr, "kernel_launch: hipFuncSetAttribute failed\n"); grid = -1; return; }
        if (hipOccupancyMaxActiveBlocksPerMultiprocessor(&per_cu, (const void*)fwd_kernel, NWAVES * 64, LDS_BYTES) != hipSuccess || per_cu < 1) fprintf(stderr, "kernel_launch: occupancy query reports %d\n", per_cu);
        (void)hipGetLastError();
        grid = cus;
    }
    if (grid < 0) return;
    if (hipMemsetAsync((char*)d_ws + WS_CTL, 0, CTL_ZERO_BYTES, stream) != hipSuccess) return;
    Args a{};
    for (int i = 0; i < 29; ++i) a.in[i] = (const float*)d_in[i];
    a.out = (float*)d_out; a.ws = (unsigned char*)d_ws;
#if MK_ONE_LAUNCH
    a.ph_lo = 0; a.ph_hi = NPHASE;
    hipLaunchKernelGGL(fwd_kernel, dim3(grid), dim3(NWAVES * 64), LDS_BYTES, stream, a);
#else
    for (int ph = 0; ph < NPHASE; ++ph) { a.ph_lo = ph; a.ph_hi = ph + 1; hipLaunchKernelGGL(fwd_kernel, dim3(grid), dim3(NWAVES * 64), LDS_BYTES, stream, a); }
#endif
}
```
